# Optimizing an MI355X kernel written in HIP

```python
import jax, jax.numpy as jnp
from jax import lax
import numpy as np

D_MODEL = 2048
BATCH = 1
SEQ = 16384
DEPTH = 1

BLOCK = 128
ROPE_THETA = 10000.0
LN_EPS = 1e-5
A_HEADS = 16
A_KV_HEADS = 2
A_GROUP = A_HEADS // A_KV_HEADS
A_HEAD_DIM = 64
A_WINDOW = 128
A_WIDTH = A_HEADS * A_HEAD_DIM
A_KV_WIDTH = A_KV_HEADS * A_HEAD_DIM
B_PATTERNS = ((128, 1), (512, 4), (2048, 16))
B_N_GROUPS = len(B_PATTERNS)
B_HEADS_PER_GROUP = 4
B_HEAD_DIM = 128
B_GROUP_WIDTH = B_HEADS_PER_GROUP * B_HEAD_DIM
B_QKV_WIDTH = B_N_GROUPS * B_GROUP_WIDTH
B_OUT_WIDTH = B_GROUP_WIDTH
N_BRANCHES = 2
IN_SIZES = (A_WIDTH, A_KV_WIDTH, A_KV_WIDTH, A_WIDTH,
            B_QKV_WIDTH, B_QKV_WIDTH, B_QKV_WIDTH, B_OUT_WIDTH,
            D_MODEL, D_MODEL)
D_IN = sum(IN_SIZES)
IN_OFFSETS = tuple(int(o) for o in np.cumsum(IN_SIZES)[:-1])
DN_ALPHA = float((2 * DEPTH) ** 0.25)
DN_BETA = float((8 * DEPTH) ** -0.25)

kernel_name = "hybrid_swa_sink_dilated_gated_deepnorm"


def apply_rope(t, positions):
    half = t.shape[-1] // 2
    inv_freq = ROPE_THETA ** (-jnp.arange(half, dtype=jnp.float32) / half)
    ang = positions.astype(jnp.float32)[..., None] * inv_freq
    cos = jnp.cos(ang)[:, :, None, :]
    sin = jnp.sin(ang)[:, :, None, :]
    t1 = t[..., :half].astype(jnp.float32)
    t2 = t[..., half:].astype(jnp.float32)
    out = jnp.concatenate([t1 * cos - t2 * sin, t2 * cos + t1 * sin], axis=-1)
    return out.astype(t.dtype)


def pad_seq(t):
    pad = (-t.shape[1]) % BLOCK
    return jnp.pad(t, [(0, 0), (0, pad)] + [(0, 0)] * (t.ndim - 2))


def banded_attention(q, k, v, max_dist, sink=None):
    n, L, kvh, g, dh = q.shape
    nb = L // BLOCK
    qb = q.reshape(n, nb, BLOCK, kvh, g, dh)
    kb = k.reshape(n, nb, BLOCK, kvh, dh)
    vb = v.reshape(n, nb, BLOCK, kvh, dh)
    zero_blk = ((0, 0), (1, 0), (0, 0), (0, 0), (0, 0))
    kk = jnp.concatenate([jnp.pad(kb, zero_blk)[:, :-1], kb], axis=2)
    vv = jnp.concatenate([jnp.pad(vb, zero_blk)[:, :-1], vb], axis=2)
    s = jnp.einsum('ncqhgd,nckhd->nchgqk', qb, kk,
                   preferred_element_type=jnp.float32) * (dh ** -0.5)
    q_idx = jnp.arange(BLOCK)[:, None] + BLOCK
    k_idx = jnp.arange(2 * BLOCK)[None, :]
    dist = q_idx - k_idx
    band = (dist >= 0) & (dist <= max_dist)
    key_pos = jnp.arange(nb)[:, None] * BLOCK - BLOCK + jnp.arange(2 * BLOCK)[None, :]
    mask = band[None] & (key_pos >= 0)[:, None, :]
    s = jnp.where(mask[None, :, None, None], s, -jnp.inf)
    m = jnp.max(s, axis=-1)
    if sink is not None:
        sk = sink.astype(jnp.float32)[None, None, :, :, None]
        m = jnp.maximum(m, sk)
    p = jnp.exp(s - m[..., None])
    denom = jnp.sum(p, axis=-1)
    if sink is not None:
        denom = denom + jnp.exp(sk - m)
    o = jnp.einsum('nchgqk,nckhd->ncqhgd', p, vv.astype(jnp.float32))
    denom_t = denom.transpose(0, 1, 4, 2, 3)
    o = o / denom_t[..., None]
    lse = (m.transpose(0, 1, 4, 2, 3) + jnp.log(denom_t)).reshape(n, L, kvh, g)
    return o.reshape(n, L, kvh, g, dh), lse


def dilated_group(q, k, v, window, dilation):
    bn, s_len, h, dh = q.shape
    L = s_len // dilation

    def to_sub(t):
        return t.reshape(bn, L, dilation, h, dh).transpose(0, 2, 1, 3, 4).reshape(bn * dilation, L, h, dh)

    qs, ks, vs = pad_seq(to_sub(q)), pad_seq(to_sub(k)), pad_seq(to_sub(v))
    o, lse = banded_attention(qs[:, :, :, None, :], ks, vs, window // dilation)
    o = o[:, :L, :, 0].reshape(bn, dilation, L, h, dh).transpose(0, 2, 1, 3, 4).reshape(bn, s_len, h, dh)
    lse = lse[:, :L, :, 0].reshape(bn, dilation, L, h).transpose(0, 2, 1, 3).reshape(bn, s_len, h)
    return o, lse


def layer_norm(z, g, b):
    z = z.astype(jnp.float32)
    mu = jnp.mean(z, axis=-1, keepdims=True)
    var = jnp.mean(jnp.square(z - mu), axis=-1, keepdims=True)
    return (z - mu) * lax.rsqrt(var + LN_EPS) * g.astype(jnp.float32) + b.astype(jnp.float32)


def hybrid_layer(x, positions, w_in, b_gate, sinks, w_pa, w_pb, w_out, ln_g, ln_b):
    bn, s_len, _ = x.shape
    h = jnp.einsum('bsd,de->bse', x, w_in)
    (qa, ka, va, gate_a, qb, kb, vb, gate_b, mg_a, mg_b) = jnp.split(h, IN_OFFSETS, axis=-1)

    qa = apply_rope(qa.reshape(bn, s_len, A_HEADS, A_HEAD_DIM), positions)
    ka = apply_rope(ka.reshape(bn, s_len, A_KV_HEADS, A_HEAD_DIM), positions)
    va = va.reshape(bn, s_len, A_KV_HEADS, A_HEAD_DIM)
    qa = qa.reshape(bn, s_len, A_KV_HEADS, A_GROUP, A_HEAD_DIM)
    o_a, _ = banded_attention(pad_seq(qa), pad_seq(ka), pad_seq(va), A_WINDOW - 1,
                              sink=sinks.reshape(A_KV_HEADS, A_GROUP))
    o_a = o_a[:, :s_len].reshape(bn, s_len, A_WIDTH)

    n_b = B_N_GROUPS * B_HEADS_PER_GROUP
    qb = apply_rope(qb.reshape(bn, s_len, n_b, B_HEAD_DIM), positions)
    kb = apply_rope(kb.reshape(bn, s_len, n_b, B_HEAD_DIM), positions)
    vb = vb.reshape(bn, s_len, n_b, B_HEAD_DIM)
    outs, lses = [], []
    for gi, (window, dilation) in enumerate(B_PATTERNS):
        sl = slice(gi * B_HEADS_PER_GROUP, (gi + 1) * B_HEADS_PER_GROUP)
        o_g, lse_g = dilated_group(qb[:, :, sl], kb[:, :, sl], vb[:, :, sl], window, dilation)
        outs.append(o_g)
        lses.append(lse_g)
    wts = jax.nn.softmax(jnp.stack(lses, axis=0), axis=0)
    o_b = jnp.sum(wts[..., None] * jnp.stack(outs, axis=0), axis=0).reshape(bn, s_len, B_OUT_WIDTH)

    y_a = jnp.einsum('bse,ed->bsd', (o_a * jax.nn.silu(gate_a.astype(jnp.float32))).astype(x.dtype), w_pa)
    y_b = jnp.einsum('bse,ed->bsd', (o_b * jax.nn.silu(gate_b.astype(jnp.float32))).astype(x.dtype), w_pb)
    merged = jax.nn.sigmoid(mg_a + b_gate[0]) * y_a + jax.nn.sigmoid(mg_b + b_gate[1]) * y_b
    sub = jnp.einsum('bsd,de->bse', merged, w_out)

    out = layer_norm(DN_ALPHA * x.astype(jnp.float32) + sub.astype(jnp.float32), ln_g, ln_b)
    return out.astype(x.dtype)


def setup_inputs(seed: int = 0) -> dict:
    key = jax.random.key(seed)
    ks = jax.random.split(key, 10)
    x = jax.random.normal(ks[0], (BATCH, SEQ, D_MODEL), jnp.float32)
    positions = jnp.broadcast_to(jnp.arange(SEQ, dtype=jnp.int32)[None, :], (BATCH, SEQ))
    col_scale = np.concatenate([
        np.full((n,), DN_BETA if i in (2, 6) else 1.0, np.float32) for i, n in enumerate(IN_SIZES)])
    w_in = (jax.random.normal(ks[1], (DEPTH, D_MODEL, D_IN), jnp.float32)
            * (D_MODEL ** -0.5) * jnp.asarray(col_scale))
    b_gate = 0.01 * jax.random.normal(ks[2], (DEPTH, N_BRANCHES, D_MODEL), jnp.float32)
    sinks = 0.5 * jax.random.normal(ks[3], (DEPTH, A_HEADS), jnp.float32)
    w_pa = jax.random.normal(ks[4], (DEPTH, A_WIDTH, D_MODEL), jnp.float32) * (A_WIDTH ** -0.5) * DN_BETA
    w_pb = jax.random.normal(ks[5], (DEPTH, B_OUT_WIDTH, D_MODEL), jnp.float32) * (B_OUT_WIDTH ** -0.5) * DN_BETA
    w_out = jax.random.normal(ks[6], (DEPTH, D_MODEL, D_MODEL), jnp.float32) * (D_MODEL ** -0.5) * DN_BETA
    ln_g = 1.0 + 0.02 * jax.random.normal(ks[7], (DEPTH, D_MODEL), jnp.float32)
    ln_b = 0.02 * jax.random.normal(ks[8], (DEPTH, D_MODEL), jnp.float32)
    return {"x": x, "positions": positions, "w_in": w_in, "b_gate": b_gate, "sinks": sinks,
            "w_pa": w_pa, "w_pb": w_pb, "w_out": w_out, "ln_g": ln_g, "ln_b": ln_b}


def reference(x, positions, w_in, b_gate, sinks, w_pa, w_pb, w_out, ln_g, ln_b):
    for layer in range(DEPTH):
        x = hybrid_layer(x, positions, w_in[layer], b_gate[layer], sinks[layer], w_pa[layer],
                         w_pb[layer], w_out[layer], ln_g[layer], ln_b[layer])
    return x
```

```cpp
#include <hip/hip_runtime.h>
#include <hip/hip_cooperative_groups.h>
#include <cstdio>
#include <cstdint>
#include <cmath>
namespace cg = cooperative_groups;

#define LAS __attribute__((address_space(3)))
typedef unsigned short bf16_t;
typedef short bf16x8 __attribute__((ext_vector_type(8)));
typedef short bf16x4 __attribute__((ext_vector_type(4)));
typedef float f32x4 __attribute__((ext_vector_type(4)));
typedef float f32x2 __attribute__((ext_vector_type(2)));
typedef unsigned u32x4 __attribute__((ext_vector_type(4)));
typedef unsigned u32x2 __attribute__((ext_vector_type(2)));

constexpr int M = 16384, D = 2048, DIN = 11520;
constexpr int OFF_QA = 0, OFF_KA = 1024, OFF_VA = 1152, OFF_GA = 1280, OFF_QB = 2304, OFF_KB = 3840, OFF_VB = 5376, OFF_GB = 6912, OFF_MGA = 7424, OFF_MGB = 9472;
constexpr int OFF_UB = 1024;
constexpr float LOG2E = 1.4426950408889634f;
constexpr float SC_QA = 0.125f * LOG2E;
constexpr float SC_QB = 0.08838834764831845f * LOG2E;
constexpr float DN_ALPHA = 1.189207115002721f;
constexpr float LN_EPS = 1e-5f;
constexpr float W8_SCALE = 64.0f;
constexpr float SU8 = 16.0f, SM8 = 32.0f;
constexpr size_t MiB = 1u << 20;
constexpr size_t WS_XB = 0;
constexpr size_t WS_WIN = 64 * MiB;
constexpr size_t WS_WP = 110 * MiB;
constexpr size_t WS_WOUT = 116 * MiB;
constexpr size_t WS_CSB = 124 * MiB;
constexpr size_t WS_CSA = 132 * MiB;
constexpr size_t WS_LSE = 136 * MiB;
constexpr size_t WS_STATS = 137 * MiB;
constexpr size_t WS_CTL = 142 * MiB;
constexpr size_t WS_H = 144 * MiB;
constexpr size_t WS_END = 504 * MiB;
constexpr int LDS_BYTES = 147456;

__device__ __forceinline__ unsigned cvt_pk_bf16(float lo, float hi) { unsigned r; asm volatile("v_cvt_pk_bf16_f32 %0, %1, %2" : "=v"(r) : "v"(lo), "v"(hi)); return r; }
__device__ __forceinline__ float bf_lo(unsigned w) { return __uint_as_float(w << 16); }
__device__ __forceinline__ float bf_hi(unsigned w) { return __uint_as_float(w & 0xffff0000u); }
__device__ __forceinline__ float fast_rcp(float x) { return __builtin_amdgcn_rcpf(x); }
__device__ __forceinline__ float fast_exp2(float x) { return __builtin_amdgcn_exp2f(x); }
__device__ __forceinline__ float sigmoidf_(float v) { return fast_rcp(1.0f + fast_exp2(-v * LOG2E)); }

__device__ __forceinline__ unsigned pack_fp8x4(float a, float b, float c, float d) {
    const unsigned lo = (unsigned)__builtin_amdgcn_cvt_pk_fp8_f32(a, b, 0, false), hi = (unsigned)__builtin_amdgcn_cvt_pk_fp8_f32(c, d, 0, false);
    return (lo & 0xffffu) | (hi << 16);
}

__device__ __forceinline__ void unpack_fp8x8(u32x2 w, f32x4& lo, f32x4& hi) {
    typedef float f2 __attribute__((ext_vector_type(2)));
    const f2 a = __builtin_amdgcn_cvt_pk_f32_fp8((int)w.x, false), b = __builtin_amdgcn_cvt_pk_f32_fp8((int)w.x, true), c = __builtin_amdgcn_cvt_pk_f32_fp8((int)w.y, false), d = __builtin_amdgcn_cvt_pk_f32_fp8((int)w.y, true);
    lo = (f32x4){a[0], a[1], b[0], b[1]}; hi = (f32x4){c[0], c[1], d[0], d[1]};
}

namespace pg8 {
constexpr int BM = 256, BK = 64, HALF = 128, HTB = HALF * BK * 2, STAGE_BYTES = 8 * HTB, NXCD = 8, WGM = 1;
__host__ __device__ __forceinline__ int lds_byte(int r, int c) { const int st = (r >> 4) * 2 + (c >> 5), rr = r & 15, cc = c & 31, ob = rr * 64 + cc * 2; return st * 1024 + (ob ^ (((ob >> 9) & 1) << 5)); }
__host__ __device__ __forceinline__ void stage_rc(int b, int& R, int& C) { const int st = b / 1024, sb = b % 1024, swz = sb ^ (((sb >> 9) & 1) << 5); R = (st >> 1) * 16 + swz / 64; C = (st & 1) * 32 + (swz % 64) / 2; }
__host__ __device__ __forceinline__ int perm32(int rho) { const int n = rho >> 4, i = rho & 15; return 8 * (i >> 2) + 4 * n + (i & 3); }

typedef int v8i_t __attribute__((ext_vector_type(8))); typedef int v4i_t __attribute__((ext_vector_type(4)));
__device__ __forceinline__ v8i_t join8(bf16x8 lo, bf16x8 hi) { const v4i_t a = __builtin_bit_cast(v4i_t, lo), b = __builtin_bit_cast(v4i_t, hi); return __builtin_shufflevector(a, b, 0, 1, 2, 3, 4, 5, 6, 7); }
struct Unit { int pm, pn, k0, nt, part; };
struct Gemm { const bf16_t* A; const bf16_t* Bt; int lda, ldb; };

__device__ __forceinline__ void tile_of(int L, int nM, int nN, int& pm, int& pn) {
    const int nwg = nM * nN; int wgid = L;
    { const int q = nwg / NXCD, r = nwg % NXCD, xcd = wgid % NXCD, off = wgid / NXCD; wgid = (xcd < r ? xcd * (q + 1) : r * (q + 1) + (xcd - r) * q) + off; }
    const int nig = WGM * nN, gid = wgid / nig, fm = gid * WGM, gsz = (nM - fm) < WGM ? (nM - fm) : WGM;
    pm = fm + ((wgid % nig) % gsz); pn = (wgid % nig) / gsz;
}
struct OrderPlain {
    int nM, nN, nwg, G, c, nt;
    __device__ __forceinline__ bool next(int i, Unit& u) const { const long L = (long)i * G + c; if (L >= nwg) return false; tile_of((int)L, nM, nN, u.pm, u.pn); u.k0 = 0; u.nt = nt; u.part = 0; return true; }
};
struct OrderList {
    int nM, nN, nwg, G, c, nt; const unsigned char* list;
    __device__ __forceinline__ bool next(int i, Unit& u) const { const long L = (long)i * G + c; if (L >= nwg) return false; int j; tile_of((int)L, nM, nN, u.pm, j); u.pn = list[j]; u.k0 = 0; u.nt = nt; u.part = 0; return true; }
};
struct OrderTwoPart {
    int nM, nN, nwg, G, c, k1, nt0, nt1;
    __device__ __forceinline__ bool next(int i, Unit& u) const { const long L = (long)(i >> 1) * G + c; if (L >= nwg) return false; tile_of((int)L, nM, nN, u.pm, u.pn);
        u.part = i & 1; u.k0 = u.part ? k1 : 0; u.nt = u.part ? nt1 : nt0; return true; }
};

template <class Epi, class Sched, bool FP8 = false>
__device__ __forceinline__ void gemm_phase(LAS unsigned char* lds, const Gemm g, const Sched& S, const Epi& E) {
    const int tid = threadIdx.x;
    const int wid = __builtin_amdgcn_readfirstlane(tid >> 6), lane = tid & 63, wr = wid >> 2, wc = wid & 3, fr = lane & 15, fq = lane >> 4;
    unsigned voffA[2], voffB[2];
#pragma unroll
    for (int i = 0; i < 2; ++i) { int R, C; stage_rc(tid * 16 + i * 8192, R, C); const int Rb = Epi::PERM ? ((R & ~31) + perm32(R & 31)) : R;
        voffA[i] = (unsigned)(R * g.lda + C) * 2u; voffB[i] = (unsigned)(Rb * g.ldb + C) * 2u; }
    const size_t kstep = (size_t)(BK * 2);
    const size_t hstepA = (size_t)HALF * g.lda * 2, hstepB = (size_t)HALF * g.ldb * 2;
    const size_t tstepA = 2 * hstepA, tstepB = 2 * hstepB;
    const unsigned ldsw = (unsigned)wid * 1024u;
    const int aoff = lds_byte(wr * 64 + fr, fq * 8), boff = lds_byte(wc * 32 + fr, fq * 8);
#define PG8_SA(b, h) (((b) * 2 + (h)) * HTB)
#define PG8_SB(b, h) ((4 + (b) * 2 + (h)) * HTB)
#define PG8_STAGE(bufoff, gbase, voff) do { _Pragma("unroll") for (int _i = 0; _i < 2; ++_i) \
        __builtin_amdgcn_global_load_lds((const unsigned*)((const char*)(gbase) + (voff)[_i]), (LAS unsigned*)(lds + (bufoff) + ldsw + _i * 8192), 16, 0, 0); } while (0)
#define PG8_LDA(dst, b, h) do { _Pragma("unroll") for (int m = 0; m < 4; ++m) { \
        if constexpr (FP8) dst##8[m] = join8(*(const LAS bf16x8*)(lds + PG8_SA(b, h) + aoff + m * 2048), *(const LAS bf16x8*)(lds + PG8_SA(b, h) + aoff + m * 2048 + 1024)); \
        else { _Pragma("unroll") for (int k = 0; k < 2; ++k) dst[m][k] = *(const LAS bf16x8*)(lds + PG8_SA(b, h) + aoff + m * 2048 + k * 1024); } } } while (0)
#define PG8_LDB(dst, b, h) do { _Pragma("unroll") for (int n = 0; n < 2; ++n) { \
        if constexpr (FP8) dst##8[n] = join8(*(const LAS bf16x8*)(lds + PG8_SB(b, h) + boff + n * 2048), *(const LAS bf16x8*)(lds + PG8_SB(b, h) + boff + n * 2048 + 1024)); \
        else { _Pragma("unroll") for (int k = 0; k < 2; ++k) dst[n][k] = *(const LAS bf16x8*)(lds + PG8_SB(b, h) + boff + n * 2048 + k * 1024); } } } while (0)
#define PG8_MMA(ai, bj, At, Bt) do { __builtin_amdgcn_s_setprio(1); \
        if constexpr (FP8) { _Pragma("unroll") for (int m = 0; m < 4; ++m) _Pragma("unroll") for (int n = 0; n < 2; ++n) \
            asm volatile("v_mfma_scale_f32_16x16x128_f8f6f4 %0, %1, %2, %0, %3, %3 op_sel_hi:[0,0,0]" : "+v"(acc[ai][bj][m][n]) : "v"(Bt##8[n]), "v"(At##8[m]), "v"(fp8_one)); } \
        else { _Pragma("unroll") for (int m = 0; m < 4; ++m) _Pragma("unroll") for (int n = 0; n < 2; ++n) _Pragma("unroll") for (int k = 0; k < 2; ++k) \
            acc[ai][bj][m][n] = __builtin_amdgcn_mfma_f32_16x16x32_bf16(Bt[n][k], At[m][k], acc[ai][bj][m][n], 0, 0, 0); } \
        __builtin_amdgcn_s_setprio(0); } while (0)
#define PG8_WAIT_V(n) asm volatile("s_waitcnt vmcnt(" #n ")" ::: "memory")
#define PG8_WAIT_L(n) asm volatile("s_waitcnt lgkmcnt(" #n ")" ::: "memory")
#define PG8_BAR __builtin_amdgcn_s_barrier()
#define PG8_SCHED __builtin_amdgcn_sched_barrier(0)
    Unit cur, nxt; int ui = 0;
    if (!S.next(0, cur)) return;
    f32x4 acc[2][2][4][2];
#pragma unroll
    for (int a = 0; a < 2; ++a)
#pragma unroll
        for (int b = 0; b < 2; ++b)
#pragma unroll
            for (int m = 0; m < 4; ++m)
#pragma unroll
                for (int n = 0; n < 2; ++n) acc[a][b][m][n] = (f32x4){0.f, 0.f, 0.f, 0.f};
    const int fp8_one = 0x7F7F7F7F;
    bf16x8 At[4][2], B0[2][2], B1[2][2]; v8i_t At8[4], B08[2], B18[2];
    const char* cA = (const char*)g.A + (size_t)cur.pm * tstepA + (size_t)cur.k0 * 2; const char* cB = (const char*)g.Bt + (size_t)cur.pn * tstepB + (size_t)cur.k0 * 2;
    PG8_STAGE(PG8_SB(0, 0), cB, voffB); PG8_STAGE(PG8_SB(0, 1), cB + hstepB, voffB); PG8_STAGE(PG8_SA(0, 0), cA, voffA); PG8_STAGE(PG8_SA(0, 1), cA + hstepA, voffA);
    if (wr == 1) PG8_BAR;
    PG8_WAIT_V(2); PG8_BAR;
    PG8_STAGE(PG8_SB(1, 0), cB + kstep, voffB); PG8_STAGE(PG8_SA(1, 0), cA + kstep, voffA); PG8_STAGE(PG8_SB(1, 1), cB + hstepB + kstep, voffB);
    PG8_WAIT_V(6); PG8_BAR;
    for (;;) {
        const bool has_next = S.next(ui + 1, nxt);
        const char* nA = has_next ? (const char*)g.A + (size_t)nxt.pm * tstepA + (size_t)nxt.k0 * 2 : cA; const char* nB = has_next ? (const char*)g.Bt + (size_t)nxt.pn * tstepB + (size_t)nxt.k0 * 2 : cB;
        const int nt = cur.nt;
        for (int t = 0; t < nt; t += 2) {
            const bool last = (t == nt - 2);
            const char* a1 = cA + (size_t)(t + 1) * kstep;
            const char* a2 = last ? nA : cA + (size_t)(t + 2) * kstep; const char* b2 = last ? nB : cB + (size_t)(t + 2) * kstep;
            const char* a3 = a2 + kstep; const char* b3 = b2 + kstep;
            PG8_LDB(B0, 0, 0); PG8_LDB(B1, 0, 1); PG8_SCHED; PG8_LDA(At, 0, 0); PG8_STAGE(PG8_SA(1, 1), a1 + hstepA, voffA);
            PG8_WAIT_V(8); PG8_WAIT_L(0); PG8_BAR; PG8_MMA(0, 0, At, B0); PG8_MMA(0, 1, At, B1); PG8_BAR; PG8_SCHED;
            PG8_LDA(At, 0, 1); PG8_STAGE(PG8_SB(0, 0), b2, voffB); PG8_STAGE(PG8_SB(0, 1), b2 + hstepB, voffB); PG8_STAGE(PG8_SA(0, 0), a2, voffA);
            PG8_WAIT_V(8); PG8_WAIT_L(0); PG8_BAR; PG8_MMA(1, 0, At, B0); PG8_MMA(1, 1, At, B1); PG8_BAR; PG8_SCHED;
            PG8_LDB(B0, 1, 0); PG8_LDB(B1, 1, 1); PG8_SCHED; PG8_LDA(At, 1, 0); PG8_STAGE(PG8_SA(0, 1), a2 + hstepA, voffA);
            PG8_WAIT_V(8); PG8_WAIT_L(0); PG8_BAR; PG8_MMA(0, 0, At, B0); PG8_MMA(0, 1, At, B1); PG8_BAR; PG8_SCHED;
            PG8_LDA(At, 1, 1); PG8_STAGE(PG8_SB(1, 0), b3, voffB); PG8_STAGE(PG8_SB(1, 1), b3 + hstepB, voffB); PG8_STAGE(PG8_SA(1, 0), a3, voffA);
            PG8_WAIT_V(8); PG8_WAIT_L(0); PG8_BAR; PG8_MMA(1, 0, At, B0); PG8_MMA(1, 1, At, B1); PG8_BAR; PG8_SCHED;
        }
        if (wr == 0) PG8_BAR;
        if constexpr (FP8) asm volatile("s_nop 15\n\ts_nop 15" ::: "memory");
        E(acc, cur, wr, wc, fr, fq);
        if (!has_next) break;
        if (!E.keep(cur)) {
#pragma unroll
            for (int a = 0; a < 2; ++a)
#pragma unroll
                for (int b = 0; b < 2; ++b)
#pragma unroll
                    for (int m = 0; m < 4; ++m)
#pragma unroll
                        for (int n = 0; n < 2; ++n) acc[a][b][m][n] = (f32x4){0.f, 0.f, 0.f, 0.f};
        }
        cur = nxt; cA = nA; cB = nB; ++ui;
        if (wr == 1) PG8_BAR;
    }
    PG8_WAIT_V(0);
    PG8_BAR;
#undef PG8_SA
#undef PG8_SB
#undef PG8_STAGE
#undef PG8_LDA
#undef PG8_LDB
#undef PG8_MMA
#undef PG8_WAIT_V
#undef PG8_WAIT_L
#undef PG8_BAR
#undef PG8_SCHED
}
}

__host__ __device__ __forceinline__ int tile_mode(int pn) { return (pn <= 4) ? 1 : (pn >= 9 && pn <= 20) ? 2 : 0; }
__host__ __device__ __forceinline__ int gemm_col_to_orig(int nprime) {
    const int pn = nprime >> 8, xp = nprime & 255, bj = xp >> 7, x = xp & 127, md = tile_mode(pn);
    if (md == 1) return 256 * pn + 64 * (x >> 5) + (x & 31) + 32 * bj;
    if (md == 2) return 256 * pn + 128 * (x >> 6) + (x & 63) + 64 * bj;
    return nprime;
}

struct Epi1 {
    static constexpr bool PERM = true;
    bf16_t* H; const f32x2* csA; const f32x2* csB; const float* bgate; int pn_off; float ascale;
    __device__ __forceinline__ bool keep(const pg8::Unit&) const { return false; }
    __device__ __forceinline__ void operator()(f32x4 (&acc)[2][2][4][2], const pg8::Unit& u, int wr, int wc, int fr, int fq) const {
        const int pn = u.pn + pn_off, md = tile_mode(pn);
        const int row0 = u.pm * 256 + wr * 64 + fr;
        int col0, cstep;
        if (md == 1) { col0 = 256 * pn + 64 * wc + 8 * fq; cstep = 32; }
        else if (md == 2) { col0 = 256 * pn + 128 * (wc >> 1) + 32 * (wc & 1) + 8 * fq; cstep = 64; }
        else { col0 = 256 * pn + 32 * wc + 8 * fq; cstep = 128; }
        const bool rope = (md == 2) || (md == 1 && (pn < 4 || wc < 2));
        if (rope) {
            const float sc = ((pn < 4) ? SC_QA : (pn >= 9 && pn < 15) ? SC_QB : 1.0f) * ascale;
#pragma unroll
            for (int ai = 0; ai < 2; ++ai)
#pragma unroll
                for (int m = 0; m < 4; ++m) {
                    const int row = row0 + ai * 128 + m * 16;
                    const f32x4* cp = (md == 1) ? (const f32x4*)(csA + (size_t)row * 32 + 8 * fq) : (const f32x4*)(csB + (size_t)row * 64 + 32 * (wc & 1) + 8 * fq);
                    const f32x4 t0 = cp[0], t1 = cp[1], t2 = cp[2], t3 = cp[3];
                    const f32x4 a0 = acc[ai][0][m][0], a1 = acc[ai][0][m][1], b0 = acc[ai][1][m][0], b1 = acc[ai][1][m][1];
                    u32x4 w0, w1;
                    w0.x = cvt_pk_bf16((a0[0] * t0[0] - b0[0] * t0[1]) * sc, (a0[1] * t0[2] - b0[1] * t0[3]) * sc);
                    w0.y = cvt_pk_bf16((a0[2] * t1[0] - b0[2] * t1[1]) * sc, (a0[3] * t1[2] - b0[3] * t1[3]) * sc);
                    w0.z = cvt_pk_bf16((a1[0] * t2[0] - b1[0] * t2[1]) * sc, (a1[1] * t2[2] - b1[1] * t2[3]) * sc);
                    w0.w = cvt_pk_bf16((a1[2] * t3[0] - b1[2] * t3[1]) * sc, (a1[3] * t3[2] - b1[3] * t3[3]) * sc);
                    w1.x = cvt_pk_bf16((b0[0] * t0[0] + a0[0] * t0[1]) * sc, (b0[1] * t0[2] + a0[1] * t0[3]) * sc);
                    w1.y = cvt_pk_bf16((b0[2] * t1[0] + a0[2] * t1[1]) * sc, (b0[3] * t1[2] + a0[3] * t1[3]) * sc);
                    w1.z = cvt_pk_bf16((b1[0] * t2[0] + a1[0] * t2[1]) * sc, (b1[1] * t2[2] + a1[1] * t2[3]) * sc);
                    w1.w = cvt_pk_bf16((b1[2] * t3[0] + a1[2] * t3[1]) * sc, (b1[3] * t3[2] + a1[3] * t3[3]) * sc);
                    bf16_t* rp = H + (size_t)row * DIN + col0;
                    *(u32x4*)(rp) = w0; *(u32x4*)(rp + cstep) = w1;
                    if (m == 3) asm volatile("" ::: "memory");
                }
        } else {
            const int act = (pn >= 29) ? 2 : ((pn >= 5 && pn <= 8) || pn == 27 || pn == 28) ? 1 : 0;
            f32x4 bv[2][2];
#pragma unroll
            for (int bj = 0; bj < 2; ++bj)
#pragma unroll
                for (int n = 0; n < 2; ++n) bv[bj][n] = (act == 2) ? *(const f32x4*)(bgate + (col0 + bj * cstep - OFF_MGA) + 4 * n) : (f32x4){0.f, 0.f, 0.f, 0.f};
#pragma unroll
            for (int ai = 0; ai < 2; ++ai)
#pragma unroll
                for (int m = 0; m < 4; ++m) {
                    bf16_t* rp = H + (size_t)(row0 + ai * 128 + m * 16) * DIN + col0;
#pragma unroll
                    for (int bj = 0; bj < 2; ++bj) {
                        f32x4 v0 = acc[ai][bj][m][0] * ascale + bv[bj][0], v1 = acc[ai][bj][m][1] * ascale + bv[bj][1];
                        if (act == 1) {
#pragma unroll
                            for (int j = 0; j < 4; ++j) { v0[j] = v0[j] * sigmoidf_(v0[j]); v1[j] = v1[j] * sigmoidf_(v1[j]); } }
                        else if (act == 2) {
#pragma unroll
                            for (int j = 0; j < 4; ++j) { v0[j] = sigmoidf_(v0[j]); v1[j] = sigmoidf_(v1[j]); } }
                        if (act != 0) {
                            const int offx = (pn >= 37) ? OFF_MGB : (pn >= 29) ? OFF_MGA : (pn >= 27) ? OFF_GB : OFF_GA;
                            unsigned char* gp = (unsigned char*)(H + (size_t)(row0 + ai * 128 + m * 16) * DIN + offx) + (col0 + bj * cstep - offx);
                            *(u32x2*)gp = (u32x2){pack_fp8x4(v0[0], v0[1], v0[2], v0[3]), pack_fp8x4(v1[0], v1[1], v1[2], v1[3])};
                        } else {
                        u32x4 w; w.x = cvt_pk_bf16(v0[0], v0[1]); w.y = cvt_pk_bf16(v0[2], v0[3]); w.z = cvt_pk_bf16(v1[0], v1[1]); w.w = cvt_pk_bf16(v1[2], v1[3]);
                        *(u32x4*)(rp + bj * cstep) = w; }
                    }
                }
        }
    }
};

struct Epi2 {
    static constexpr bool PERM = true;
    const bf16_t* H; unsigned char* MG8; float oscale;
    __device__ __forceinline__ bool keep(const pg8::Unit& u) const { return u.part == 0; }
    __device__ __forceinline__ void operator()(f32x4 (&acc)[2][2][4][2], const pg8::Unit& u, int wr, int wc, int fr, int fq) const {
        const int row0 = u.pm * 256 + wr * 64 + fr, col0 = u.pn * 256 + wc * 32 + 8 * fq;
        if (u.part == 0) {
#pragma unroll
            for (int ai = 0; ai < 2; ++ai)
#pragma unroll
                for (int m = 0; m < 4; ++m) {
                    const bf16_t* hrow = H + (size_t)(row0 + ai * 128 + m * 16) * DIN;
#pragma unroll
                    for (int bj = 0; bj < 2; ++bj) {
                        const u32x2 sa = *(const u32x2*)((const unsigned char*)(hrow + OFF_MGA) + col0 + bj * 128), sb = *(const u32x2*)((const unsigned char*)(hrow + OFF_MGB) + col0 + bj * 128);
                        f32x4 a0, a1, b0, b1; unpack_fp8x8(sa, a0, a1); unpack_fp8x8(sb, b0, b1);
                        f32x4 r0, r1;
#pragma unroll
                        for (int e = 0; e < 4; ++e) { r0[e] = a0[e] * fast_rcp(fmaxf(b0[e], 1e-30f)); r1[e] = a1[e] * fast_rcp(fmaxf(b1[e], 1e-30f)); }
                        acc[ai][bj][m][0] *= r0; acc[ai][bj][m][1] *= r1;
                    }
                    if (m == 3) asm volatile("" ::: "memory");
                }
        } else {
#pragma unroll
            for (int ai = 0; ai < 2; ++ai)
#pragma unroll
                for (int m = 0; m < 4; ++m) {
                    const size_t rr = (size_t)(row0 + ai * 128 + m * 16);
                    const bf16_t* hrow = H + rr * DIN; unsigned char* op = MG8 + rr * D + col0;
#pragma unroll
                    for (int bj = 0; bj < 2; ++bj) {
                        const u32x2 sbw = *(const u32x2*)((const unsigned char*)(hrow + OFF_MGB) + col0 + bj * 128);
                        f32x4 b0, b1; unpack_fp8x8(sbw, b0, b1);
                        const f32x4 v0 = acc[ai][bj][m][0] * oscale * b0, v1 = acc[ai][bj][m][1] * oscale * b1;
                        const unsigned p0 = pack_fp8x4(v0[0], v0[1], v0[2], v0[3]), p1 = pack_fp8x4(v1[0], v1[1], v1[2], v1[3]);
                        *(u32x2*)(op + bj * 128) = (u32x2){p0, p1};
                    }
                    if (m == 3) asm volatile("" ::: "memory");
                }
        }
    }
};

struct Epi3 {
    static constexpr bool PERM = false;
    const float* x; _Float16* z16; f32x2* stats; float ascale;
    __device__ __forceinline__ bool keep(const pg8::Unit&) const { return false; }
    __device__ __forceinline__ void operator()(f32x4 (&acc)[2][2][4][2], const pg8::Unit& u, int wr, int wc, int fr, int fq) const {
        const int row0 = u.pm * 256 + wr * 64 + fr, col0 = u.pn * 256 + wc * 32 + 4 * fq;
#pragma unroll
        for (int ai = 0; ai < 2; ++ai)
#pragma unroll
            for (int m = 0; m < 4; ++m) {
                const int row = row0 + ai * 128 + m * 16; const size_t off = (size_t)row * D + col0;
                float s = 0.f, q = 0.f;
#pragma unroll
                for (int bj = 0; bj < 2; ++bj)
#pragma unroll
                    for (int n = 0; n < 2; ++n) {
                        const f32x4 xv = *(const f32x4*)(x + off + bj * 128 + n * 16);
                        const f32x4 z = xv * DN_ALPHA + acc[ai][bj][m][n] * ascale;
                        { typedef _Float16 h4 __attribute__((ext_vector_type(4))); *(h4*)(z16 + off + bj * 128 + n * 16) = (h4){(_Float16)z[0], (_Float16)z[1], (_Float16)z[2], (_Float16)z[3]}; }
                        s += (z[0] + z[1]) + (z[2] + z[3]); q += (z[0] * z[0] + z[1] * z[1]) + (z[2] * z[2] + z[3] * z[3]);
                    }
                s += __shfl_xor(s, 16); s += __shfl_xor(s, 32); q += __shfl_xor(q, 16); q += __shfl_xor(q, 32);
                if (fq == 0) stats[(size_t)row * 32 + u.pn * 4 + wc] = (f32x2){s, q};
                asm volatile("" ::: "memory");
            }
    }
};

__device__ __forceinline__ void transpose_item(const float* W, int N, bf16_t* WT, int ldt, int k0, int n_src, int n_dst, int kofs, LAS float* scr, int lane) {
    const int r8 = lane >> 3, c4 = lane & 7;
    f32x4 v[8];
#pragma unroll
    for (int i = 0; i < 8; ++i) v[i] = *(const f32x4*)(W + (size_t)(k0 + r8 + 8 * i) * N + n_src + 4 * c4);
#pragma unroll
    for (int i = 0; i < 8; ++i) { LAS float* d = scr + (r8 + 8 * i) * 33 + 4 * c4; d[0] = v[i][0]; d[1] = v[i][1]; d[2] = v[i][2]; d[3] = v[i][3]; }
    asm volatile("s_waitcnt lgkmcnt(0)" ::: "memory");
    const int c = lane & 7;
#pragma unroll
    for (int j = 0; j < 4; ++j) { const int n = (lane >> 3) + 8 * j; const LAS float* s = scr + (8 * c) * 33 + n;
        u32x4 o; o.x = cvt_pk_bf16(s[0 * 33], s[1 * 33]); o.y = cvt_pk_bf16(s[2 * 33], s[3 * 33]); o.z = cvt_pk_bf16(s[4 * 33], s[5 * 33]); o.w = cvt_pk_bf16(s[6 * 33], s[7 * 33]);
        *(u32x4*)(WT + (size_t)(n_dst + n) * ldt + kofs + k0 + 8 * c) = o; }
    asm volatile("s_waitcnt lgkmcnt(0)" ::: "memory");
}

__device__ __forceinline__ void transpose_item_fp8(const float* W, int N, unsigned char* W8, int pitch, int kofs, int k0, int n_src, int n_dst, float scale, LAS float* scr, int lane) {
    const int r8 = lane >> 3, c4 = lane & 7;
    f32x4 v[8];
#pragma unroll
    for (int i = 0; i < 8; ++i) v[i] = *(const f32x4*)(W + (size_t)(k0 + r8 + 8 * i) * N + n_src + 4 * c4);
#pragma unroll
    for (int i = 0; i < 8; ++i) { LAS float* d = scr + (r8 + 8 * i) * 33 + 4 * c4; d[0] = v[i][0]; d[1] = v[i][1]; d[2] = v[i][2]; d[3] = v[i][3]; }
    asm volatile("s_waitcnt lgkmcnt(0)" ::: "memory");
    const int n = lane & 31, cp = lane >> 5;
#pragma unroll
    for (int q = 0; q < 2; ++q) { const int ck = (2 * cp + q) * 16; const LAS float* sp = scr + ck * 33 + n; u32x4 o;
#pragma unroll
        for (int w = 0; w < 4; ++w) o[w] = pack_fp8x4(sp[(4 * w) * 33] * scale, sp[(4 * w + 1) * 33] * scale, sp[(4 * w + 2) * 33] * scale, sp[(4 * w + 3) * 33] * scale);
        *(u32x4*)(W8 + (size_t)(n_dst + n) * pitch + kofs + k0 + ck) = o; }
    asm volatile("s_waitcnt lgkmcnt(0)" ::: "memory");
}

template <int DH, bool IS_A>
__device__ __forceinline__ void attn_task(const LAS unsigned char* Kl, const LAS unsigned char* Vl, const bf16x8 (&qf)[DH / 32], const u32x2 (&gwv)[DH / 16], bf16_t* orow,
                                          int i0, int jlo, float sink2, float* lse_ptr, int lane, unsigned char* u8row) {
    constexpr int KS = (DH == 128) ? 272 : 144, VS = (DH == 128) ? 288 : 160, NKS = DH / 32, NDT = DH / 16;
    const int c16 = lane & 15, g = lane >> 4;
    f32x4 s[9];
    const LAS unsigned char* kp = Kl + (i0 + c16) * KS + 16 * g;
    bf16x8 kf[2][9];
#pragma unroll
    for (int T = 0; T < 9; ++T) { s[T] = (f32x4){0.f, 0.f, 0.f, 0.f}; kf[0][T] = *(const LAS bf16x8*)(kp + T * 16 * KS); }
#pragma unroll
    for (int ks = 0; ks < NKS; ++ks) {
        if (ks + 1 < NKS) {
#pragma unroll
            for (int T = 0; T < 9; ++T) kf[(ks + 1) & 1][T] = *(const LAS bf16x8*)(kp + T * 16 * KS + (ks + 1) * 64); }
        __builtin_amdgcn_sched_barrier(0);
#pragma unroll
        for (int T = 0; T < 9; ++T) s[T] = __builtin_amdgcn_mfma_f32_16x16x32_bf16(kf[ks & 1][T], qf[ks], s[T], 0, 0, 0);
        __builtin_amdgcn_sched_barrier(0);
    }
    const int i = i0 + c16; const int jmin = max(i + (IS_A ? 1 : 0), jlo), jmax = i + 128;
    float mx = -INFINITY;
#pragma unroll
    for (int T = 0; T < 9; ++T)
#pragma unroll
        for (int r = 0; r < 4; ++r) { const int j = i0 + 16 * T + 4 * g + r; const bool ok = (j >= jmin) && (j <= jmax); const float v = ok ? s[T][r] : -INFINITY; s[T][r] = v; mx = fmaxf(mx, v); }
    mx = fmaxf(mx, __shfl_xor(mx, 16)); mx = fmaxf(mx, __shfl_xor(mx, 32));
    if (IS_A) mx = fmaxf(mx, sink2);
    float sum = 0.f;
#pragma unroll
    for (int T = 0; T < 9; ++T)
#pragma unroll
        for (int r = 0; r < 4; ++r) { const float p = fast_exp2(s[T][r] - mx); s[T][r] = p; sum += p; }
    sum += __shfl_xor(sum, 16); sum += __shfl_xor(sum, 32);
    if (IS_A) sum += fast_exp2(sink2 - mx);
    bf16x8 pf[4];
#pragma unroll
    for (int k = 0; k < 4; ++k) { u32x4 w; w.x = cvt_pk_bf16(s[2 * k][0], s[2 * k][1]); w.y = cvt_pk_bf16(s[2 * k][2], s[2 * k][3]); w.z = cvt_pk_bf16(s[2 * k + 1][0], s[2 * k + 1][1]); w.w = cvt_pk_bf16(s[2 * k + 1][2], s[2 * k + 1][3]);
        pf[k] = __builtin_bit_cast(bf16x8, w); }
    bf16x4 p8; { u32x2 w; w.x = cvt_pk_bf16(s[8][0], s[8][1]); w.y = cvt_pk_bf16(s[8][2], s[8][3]); p8 = __builtin_bit_cast(bf16x4, w); }
    const int q4 = c16 >> 2, p4 = c16 & 3;
    const LAS unsigned char* vp = Vl + (i0 + 4 * g + q4) * VS + 8 * p4;
    const float inv = fast_rcp(sum);
    bf16x4 vv[2][9];
#pragma unroll
    for (int r9 = 0; r9 < 9; ++r9) vv[0][r9] = __builtin_amdgcn_ds_read_tr16_b64_v4i16((LAS bf16x4*)(vp + (16 * r9) * VS));
#pragma unroll
    for (int dt = 0; dt < NDT; ++dt) {
        if (dt + 1 < NDT) {
#pragma unroll
            for (int r9 = 0; r9 < 9; ++r9) vv[(dt + 1) & 1][r9] = __builtin_amdgcn_ds_read_tr16_b64_v4i16((LAS bf16x4*)(vp + (16 * r9) * VS + (dt + 1) * 32)); }
        __builtin_amdgcn_sched_barrier(0);
        f32x4 o = (f32x4){0.f, 0.f, 0.f, 0.f};
#pragma unroll
        for (int k = 0; k < 4; ++k) {
            const bf16x4 lo = vv[dt & 1][2 * k], hi = vv[dt & 1][2 * k + 1];
            o = __builtin_amdgcn_mfma_f32_16x16x32_bf16((bf16x8){lo[0], lo[1], lo[2], lo[3], hi[0], hi[1], hi[2], hi[3]}, pf[k], o, 0, 0, 0);
        }
        { const bf16x4 l8 = vv[dt & 1][8];
          o = __builtin_amdgcn_mfma_f32_16x16x32_bf16((bf16x8){l8[0], l8[1], l8[2], l8[3], l8[0], l8[1], l8[2], l8[3]}, (bf16x8){p8[0], p8[1], p8[2], p8[3], 0, 0, 0, 0}, o, 0, 0, 0); }
        __builtin_amdgcn_sched_barrier(0);
        o = o * inv;
        if (IS_A) { typedef float f2 __attribute__((ext_vector_type(2))); const f2 ga = __builtin_amdgcn_cvt_pk_f32_fp8((int)gwv[dt].x, false), gb = __builtin_amdgcn_cvt_pk_f32_fp8((int)gwv[dt].x, true);
            o[0] *= ga[0] * SU8; o[1] *= ga[1] * SU8; o[2] *= gb[0] * SU8; o[3] *= gb[1] * SU8;
            *(unsigned*)(u8row + 16 * dt + 4 * g) = pack_fp8x4(o[0], o[1], o[2], o[3]); }
        else *(unsigned*)((unsigned char*)orow + 16 * dt + 4 * g) = pack_fp8x4(o[0] * SU8, o[1] * SU8, o[2] * SU8, o[3] * SU8);
    }
    if (!IS_A) { if (g == 0) *lse_ptr = mx + __builtin_amdgcn_logf(sum); }
}

template <int DH>
__device__ __forceinline__ void load_kv(LAS unsigned char* Kl, LAS unsigned char* Vl, const bf16_t* Hk, const bf16_t* Hv, long tok0, int tstride, int jlo, int tid) {
    constexpr int KS = (DH == 128) ? 272 : 144, VS = (DH == 128) ? 288 : 160, CPR = DH / 8, PER = 256 * CPR / 512;
    u32x4 kv[PER], vv[PER];
#pragma unroll
    for (int c = 0; c < PER; ++c) { const int idx = c * 512 + tid, row = idx / CPR, ch = idx % CPR;
        if (row >= jlo) { const size_t off = (size_t)(tok0 + (long)row * tstride) * DIN + ch * 8; kv[c] = *(const u32x4*)(Hk + off); vv[c] = *(const u32x4*)(Hv + off); }
        else { kv[c] = (u32x4){0u, 0u, 0u, 0u}; vv[c] = (u32x4){0u, 0u, 0u, 0u}; } }
#pragma unroll
    for (int c = 0; c < PER; ++c) { const int idx = c * 512 + tid, row = idx / CPR, ch = idx % CPR;
        *(LAS u32x4*)(Kl + row * KS + ch * 16) = kv[c]; *(LAS u32x4*)(Vl + row * VS + ch * 16) = vv[c]; }
}


__device__ __forceinline__ void own_barrier(unsigned* cnt, unsigned G) {
    asm volatile("s_waitcnt vmcnt(0) lgkmcnt(0)" ::: "memory");
    __syncthreads();
    if (threadIdx.x == 0) {
        __builtin_amdgcn_fence(__ATOMIC_RELEASE, "agent"); asm volatile("s_waitcnt vmcnt(0)" ::: "memory");
        unsigned target;
        if ((G & 7u) == 0u) { target = 8u;
            const unsigned old = __hip_atomic_fetch_add(cnt + 64 * (1 + (blockIdx.x & 7)), 1u, __ATOMIC_RELAXED, __HIP_MEMORY_SCOPE_AGENT);
            if (old + 1u == (G >> 3)) __hip_atomic_fetch_add(cnt, 1u, __ATOMIC_RELAXED, __HIP_MEMORY_SCOPE_AGENT); }
        else { target = G; __hip_atomic_fetch_add(cnt, 1u, __ATOMIC_RELAXED, __HIP_MEMORY_SCOPE_AGENT); }
        unsigned spins = 0;
        while (__hip_atomic_load(cnt, __ATOMIC_RELAXED, __HIP_MEMORY_SCOPE_AGENT) < target && ++spins < (1u << 22)) __builtin_amdgcn_s_sleep(1);
        __builtin_amdgcn_fence(__ATOMIC_ACQUIRE, "agent"); asm volatile("s_waitcnt vmcnt(0)" ::: "memory");
    }
    __syncthreads();
}
#define GRID_SYNC() do { if (seam_no == 0) { asm volatile("s_waitcnt vmcnt(0) lgkmcnt(0)" ::: "memory"); grid.sync(); } else own_barrier((unsigned*)(ws + WS_CTL) + 1024 * seam_no, (unsigned)G); ++seam_no; } while (0)
struct Args {
    const float* x; const int* pos; const float* w_in; const float* b_gate; const float* sinks; const float* w_pa; const float* w_pb; const float* w_out; const float* ln_g; const float* ln_b;
    float* out; unsigned char* ws;
    float inv_freq[64];
    unsigned char tl_bf16[48], tl_fp8[48];
    int n_bf16, n_fp8; unsigned long long fp8mask;
};

__global__ void __launch_bounds__(512, 2) hybrid_fwd(Args a) {
    extern __shared__ __attribute__((aligned(16))) unsigned char lds_raw[];
    LAS unsigned char* lds = (LAS unsigned char*)lds_raw;
    cg::grid_group grid = cg::this_grid();
    int tid = threadIdx.x, lane = tid & 63; const int wave = __builtin_amdgcn_readfirstlane(tid >> 6);
    const int G = gridDim.x, bx = blockIdx.x;
#define PHASE_LOCAL() do { asm volatile("" : "+v"(tid)); lane = tid & 63; asm volatile("" : "+v"(lane)); } while (0)
    unsigned char* ws = a.ws; int seam_no = 0;
    bf16_t* XB = (bf16_t*)(ws + WS_XB); bf16_t* WinT = (bf16_t*)(ws + WS_WIN); bf16_t* WpT = (bf16_t*)(ws + WS_WP); bf16_t* WoutT = (bf16_t*)(ws + WS_WOUT);
    f32x2* csB = (f32x2*)(ws + WS_CSB); f32x2* csA = (f32x2*)(ws + WS_CSA); float* LSE = (float*)(ws + WS_LSE); f32x2* STATS = (f32x2*)(ws + WS_STATS);
    bf16_t* H = (bf16_t*)(ws + WS_H); bf16_t* MG = (bf16_t*)(ws + WS_XB);
    unsigned char* U8 = (unsigned char*)a.out + 32 * MiB;
    bf16_t* OG = (bf16_t*)((unsigned char*)a.out + 56 * MiB);
    unsigned char* U8_unused = (unsigned char*)a.out;
    unsigned char* MG8 = (unsigned char*)(ws + WS_XB);
    unsigned char* Wp8 = (unsigned char*)(ws + WS_WP); unsigned char* Wout8 = (unsigned char*)(ws + WS_WOUT);
    _Float16* Z16 = (_Float16*)(ws + WS_H);
    unsigned char* XB8 = (unsigned char*)a.out;

    if (bx == 0 && tid < 72) __hip_atomic_store((unsigned*)(ws + WS_CTL) + 1024 * (tid / 9) + 64 * (tid % 9), 0u, __ATOMIC_RELAXED, __HIP_MEMORY_SCOPE_AGENT);
    {
        const size_t gt = (size_t)bx * 512 + tid, GT = (size_t)G * 512;
        {
            const size_t NCH = (size_t)M * D / 8;
            for (size_t i0 = gt; i0 < NCH; i0 += 4 * GT) {
                f32x4 v[4][2];
#pragma unroll
                for (int u = 0; u < 4; ++u) { const size_t i = i0 + (size_t)u * GT; if (i < NCH) { v[u][0] = ((const f32x4*)a.x)[2 * i]; v[u][1] = ((const f32x4*)a.x)[2 * i + 1]; } }
#pragma unroll
                for (int u = 0; u < 4; ++u) { const size_t i = i0 + (size_t)u * GT; if (i < NCH) {
                    u32x4 w; w.x = cvt_pk_bf16(v[u][0][0], v[u][0][1]); w.y = cvt_pk_bf16(v[u][0][2], v[u][0][3]); w.z = cvt_pk_bf16(v[u][1][0], v[u][1][1]); w.w = cvt_pk_bf16(v[u][1][2], v[u][1][3]);
                    if (a.n_bf16 > 0) ((u32x4*)XB)[i] = w;
                    const unsigned p0 = pack_fp8x4(v[u][0][0], v[u][0][1], v[u][0][2], v[u][0][3]), p1 = pack_fp8x4(v[u][1][0], v[u][1][1], v[u][1][2], v[u][1][3]);
                    ((u32x2*)XB8)[i] = (u32x2){p0, p1}; } }
            }
        }
        for (size_t i = gt; i < (size_t)M * 64; i += GT) {
            const int t = (int)(i >> 6), j = (int)(i & 63);
            const float ang = (float)a.pos[t] * a.inv_freq[j];
            const double rev = (double)ang * 0.15915494309189535; const float fr = (float)(rev - __builtin_rint(rev));
            const f32x2 cs = (f32x2){__builtin_amdgcn_cosf(fr), __builtin_amdgcn_sinf(fr)};
            csB[i] = cs; if ((j & 1) == 0) csA[(size_t)t * 32 + (j >> 1)] = cs;
        }
        LAS float* scr = (LAS float*)(lds + wave * 16384);
        const int gw = bx * 8 + wave, NGW = G * 8;
        constexpr int I_IN = (D / 64) * (DIN / 32);
        for (int it = gw; it < I_IN; it += NGW) { const int nb = it % (DIN / 32), kb = it / (DIN / 32);
            if ((a.fp8mask >> (nb >> 3)) & 1ull) transpose_item_fp8(a.w_in, DIN, (unsigned char*)WinT, 4096, 0, 64 * kb, gemm_col_to_orig(32 * nb), 32 * nb, W8_SCALE, scr, lane);
            else transpose_item(a.w_in, DIN, WinT, D, 64 * kb, gemm_col_to_orig(32 * nb), 32 * nb, 0, scr, lane); }
    }
    GRID_SYNC();

    {
        if (a.n_fp8 > 0) {
            pg8::Gemm g{(const bf16_t*)XB8, WinT, D / 2, D}; pg8::OrderList S{M / 256, a.n_fp8, (M / 256) * a.n_fp8, G, bx, D / 128, a.tl_fp8};
            Epi1 E{H, csA, csB, a.b_gate, 0, 1.0f / W8_SCALE};
            pg8::gemm_phase<Epi1, pg8::OrderList, true>(lds, g, S, E);
        }
        {
            const int nwg = (M / 256) * (a.n_fp8 > 0 ? a.n_fp8 : a.n_bf16), rem = nwg % G; const int first = rem ? rem : 0, nhelp = G - first;
            if (bx >= first) {
                LAS float* scr = (LAS float*)(lds + wave * 16384);
                const int gw = (bx - first) * 8 + wave, NGW = nhelp * 8;
                constexpr int I_PA = (1024 / 64) * (D / 32), I_PB = (512 / 64) * (D / 32), I_OUT = (D / 64) * (D / 32);
                for (int it = gw; it < I_PA + I_PB + I_OUT; it += NGW) {
                    int r = it;
                    if (r < I_PA) { const int nb = r % (D / 32), kb = r / (D / 32); transpose_item_fp8(a.w_pa, D, Wp8, 1536, 0, 64 * kb, 32 * nb, 32 * nb, W8_SCALE, scr, lane); continue; } r -= I_PA;
                    if (r < I_PB) { const int nb = r % (D / 32), kb = r / (D / 32); transpose_item_fp8(a.w_pb, D, Wp8, 1536, 1024, 64 * kb, 32 * nb, 32 * nb, W8_SCALE, scr, lane); continue; } r -= I_PB;
                    { const int nb = r % (D / 32), kb = r / (D / 32); transpose_item_fp8(a.w_out, D, Wout8, 2048, 0, 64 * kb, 32 * nb, 32 * nb, W8_SCALE, scr, lane); }
                }
            }
        }
    }
    GRID_SYNC();

    {
        constexpr int N_A = 256, N_B = 1536;
        const bool xmap = (G % 8 == 0) && (N_A % 8 == 0) && (N_B % 8 == 0);
        const int xcd = bx & 7, jx = bx >> 3, perx = G >> 3;
        for (int i0 = bx; i0 < N_A + N_B; i0 += G) {
            int it = i0;
            if (xmap) { const int k = i0 / G;
                if (i0 < N_A) it = xcd * (N_A / 8) + k * perx + jx;
                else { const int kb = (i0 - N_A) / G; it = N_A + xcd * (N_B / 8) + kb * perx + jx; } }
            __syncthreads();
            if (it < N_A) {
                const int kvh = it & 1, b = it >> 1;
                LAS unsigned char* Kl = lds; LAS unsigned char* Vl = lds + 256 * 144;
                const int jlo = (b == 0) ? 128 : 0;
                load_kv<64>(Kl, Vl, H + OFF_KA + kvh * 64, H + OFF_VA + kvh * 64, (long)(b - 1) * 128, 1, jlo, tid);
                __syncthreads();
                const int head = kvh * 8 + wave; const float sink2 = a.sinks[head] * LOG2E;
                const int g4 = lane >> 4;
                bf16x8 qn[2]; u32x2 gn[4];
                { const size_t tok = (size_t)b * 128 + (lane & 15); const bf16_t* qr = H + tok * DIN + OFF_QA + head * 64; const bf16_t* gr = (const bf16_t*)((const unsigned char*)(H + tok * DIN + OFF_GA) + head * 64);
#pragma unroll
                  for (int ks = 0; ks < 2; ++ks) qn[ks] = *(const bf16x8*)(qr + ks * 32 + 8 * g4);
#pragma unroll
                  for (int dt = 0; dt < 4; ++dt) gn[dt] = (u32x2){*(const unsigned*)((const unsigned char*)gr + 16 * dt + 4 * g4), 0u}; }
                for (int c = 0; c < 8; ++c) {
                    const size_t tok = (size_t)b * 128 + c * 16 + (lane & 15);
                    const bf16x8 qc[2] = {qn[0], qn[1]}; const u32x2 gc[4] = {gn[0], gn[1], gn[2], gn[3]};
                    if (c < 7) { const size_t tn = tok + 16; const bf16_t* qr = H + tn * DIN + OFF_QA + head * 64; const bf16_t* gr = (const bf16_t*)((const unsigned char*)(H + tn * DIN + OFF_GA) + head * 64);
#pragma unroll
                        for (int ks = 0; ks < 2; ++ks) qn[ks] = *(const bf16x8*)(qr + ks * 32 + 8 * g4);
#pragma unroll
                        for (int dt = 0; dt < 4; ++dt) gn[dt] = (u32x2){*(const unsigned*)((const unsigned char*)gr + 16 * dt + 4 * g4), 0u}; }
                    attn_task<64, true>(Kl, Vl, qc, gc, nullptr, c * 16, jlo, sink2, nullptr, lane, U8 + tok * 1536 + head * 64);
                }
            } else {
                const int bi = it - N_A, grp = bi >> 9, rem = bi & 511, hs = rem >> 7, rb = rem & 127;
                const int dsh = 2 * grp, d = 1 << dsh;
                const int nblk = 128 >> dsh, r = rb / nblk, b = rb % nblk;
                LAS unsigned char* Kl = lds; LAS unsigned char* Vl = lds + 256 * 272;
                const int jlo = (b == 0) ? 128 : 0;
                const int colh = grp * 512 + hs * 128;
                load_kv<128>(Kl, Vl, H + OFF_KB + colh, H + OFF_VB + colh, ((long)(b - 1) * 128) * d + r, d, jlo, tid);
                __syncthreads();
                const size_t tok = ((size_t)b * 128 + wave * 16 + (lane & 15)) * d + r;
                const bf16_t* qrow = H + tok * DIN + OFF_QB + colh;
                bf16x8 qb4[4]; u32x2 gdum[8];
#pragma unroll
                for (int ks = 0; ks < 4; ++ks) qb4[ks] = *(const bf16x8*)(qrow + ks * 32 + 8 * (lane >> 4));
#pragma unroll
                for (int dt = 0; dt < 8; ++dt) gdum[dt] = (u32x2){0u, 0u};
                attn_task<128, false>(Kl, Vl, qb4, gdum, (bf16_t*)((unsigned char*)OG + ((size_t)grp * M + tok) * 512 + hs * 128), wave * 16, jlo, 0.f, LSE + ((size_t)grp * M + tok) * 4 + hs, lane, nullptr);
            }
        }
    }
    GRID_SYNC();

    {
        const int gw = bx * 8 + wave, NGW = G * 8;
        const int hs = lane >> 4, dc = (lane & 15) * 8;
        for (int t0 = gw; t0 < M; t0 += 2 * NGW) {
            float lw[2][3]; u32x2 ov[2][3], gv[2]; int tt[2];
#pragma unroll
            for (int u = 0; u < 2; ++u) { const int t = (t0 + u * NGW < M) ? t0 + u * NGW : t0; tt[u] = t;
                const bf16_t* hp = H + (size_t)t * DIN;
#pragma unroll
                for (int g3 = 0; g3 < 3; ++g3) { lw[u][g3] = LSE[((size_t)g3 * M + t) * 4 + hs]; ov[u][g3] = *(const u32x2*)((const unsigned char*)OG + ((size_t)g3 * M + t) * 512 + hs * 128 + dc); }
                gv[u] = *(const u32x2*)((const unsigned char*)(hp + OFF_GB) + hs * 128 + dc); }
#pragma unroll
            for (int u = 0; u < 2; ++u) {
                const float mxl = fmaxf(lw[u][0], fmaxf(lw[u][1], lw[u][2]));
                float w0 = fast_exp2(lw[u][0] - mxl), w1 = fast_exp2(lw[u][1] - mxl), w2 = fast_exp2(lw[u][2] - mxl);
                const float iw = fast_rcp(w0 + w1 + w2); w0 *= iw; w1 *= iw; w2 *= iw;
                f32x4 a0, a1, b0, b1, c0, c1, g0, g1;
                unpack_fp8x8(ov[u][0], a0, a1); unpack_fp8x8(ov[u][1], b0, b1); unpack_fp8x8(ov[u][2], c0, c1); unpack_fp8x8(gv[u], g0, g1);
                const f32x4 r0 = (a0 * w0 + b0 * w1 + c0 * w2) * g0, r1 = (a1 * w0 + b1 * w1 + c1 * w2) * g1;
                const unsigned p0 = pack_fp8x4(r0[0], r0[1], r0[2], r0[3]), p1 = pack_fp8x4(r1[0], r1[1], r1[2], r1[3]);
                if (u == 0 || tt[1] != tt[0]) *(u32x2*)(U8 + (size_t)tt[u] * 1536 + 1024 + hs * 128 + dc) = (u32x2){p0, p1};
            }
        }
    }
    GRID_SYNC();

    {
        pg8::Gemm g{(const bf16_t*)U8, (const bf16_t*)Wp8, 768, 768}; pg8::OrderTwoPart S{M / 256, D / 256, (M / 256) * (D / 256), G, bx, 512, 8, 4};
        Epi2 E{H, MG8, SM8 / (SU8 * W8_SCALE)};
        pg8::gemm_phase<Epi2, pg8::OrderTwoPart, true>(lds, g, S, E);
    }
    GRID_SYNC();

    {
        pg8::Gemm g{(const bf16_t*)MG8, (const bf16_t*)Wout8, D / 2, D / 2}; pg8::OrderPlain S{M / 256, D / 256, (M / 256) * (D / 256), G, bx, D / 128};
        Epi3 E{a.x, Z16, STATS, 1.0f / (SM8 * W8_SCALE)};
        pg8::gemm_phase<Epi3, pg8::OrderPlain, true>(lds, g, S, E);
    }
    GRID_SYNC();

    {
        const int xcd = bx & 7, cu_in_x = bx >> 3, per_x = G >> 3;
        const int gw = (G % 8 == 0) ? (cu_in_x * 8 + wave) : (bx * 8 + wave), NGW = (G % 8 == 0) ? per_x * 8 : G * 8;
        const int row_base = (G % 8 == 0) ? xcd * (M / 8) : 0, row_cnt = (G % 8 == 0) ? (M / 8) : M;
        typedef _Float16 h8 __attribute__((ext_vector_type(8)));
        f32x4 gg[8], bb[8];
#pragma unroll
        for (int j = 0; j < 4; ++j) { gg[2 * j] = *(const f32x4*)(a.ln_g + 512 * j + 8 * lane); gg[2 * j + 1] = *(const f32x4*)(a.ln_g + 512 * j + 8 * lane + 4);
                                      bb[2 * j] = *(const f32x4*)(a.ln_b + 512 * j + 8 * lane); bb[2 * j + 1] = *(const f32x4*)(a.ln_b + 512 * j + 8 * lane + 4); }
        for (int tl = gw; tl < row_cnt; tl += 2 * NGW) {
            const int t = row_base + tl; const int t1 = (tl + NGW < row_cnt) ? t + NGW : t;
            const f32x2 p0 = (lane < 32) ? STATS[(size_t)t * 32 + lane] : (f32x2){0.f, 0.f};
            const f32x2 p1 = (lane < 32) ? STATS[(size_t)t1 * 32 + lane] : (f32x2){0.f, 0.f};
            h8 z0[4], z1[4];
#pragma unroll
            for (int j = 0; j < 4; ++j) { z0[j] = *(const h8*)(Z16 + (size_t)t * D + 512 * j + 8 * lane); z1[j] = *(const h8*)(Z16 + (size_t)t1 * D + 512 * j + 8 * lane); }
            float s0 = p0.x, q0 = p0.y, s1 = p1.x, q1 = p1.y;
#pragma unroll
            for (int o = 1; o < 64; o <<= 1) { s0 += __shfl_xor(s0, o); q0 += __shfl_xor(q0, o); s1 += __shfl_xor(s1, o); q1 += __shfl_xor(q1, o); }
            const float m0 = s0 * (1.0f / D), m1 = s1 * (1.0f / D);
            const float r0 = 1.0f / sqrtf(fmaxf(q0 * (1.0f / D) - m0 * m0, 0.f) + LN_EPS), r1 = 1.0f / sqrtf(fmaxf(q1 * (1.0f / D) - m1 * m1, 0.f) + LN_EPS);
            float* o0 = a.out + (size_t)t * D + 8 * lane; float* o1 = a.out + (size_t)t1 * D + 8 * lane;
#pragma unroll
            for (int j = 0; j < 4; ++j) {
                const f32x4 a0 = (f32x4){(float)z0[j][0], (float)z0[j][1], (float)z0[j][2], (float)z0[j][3]}, a1 = (f32x4){(float)z0[j][4], (float)z0[j][5], (float)z0[j][6], (float)z0[j][7]};
                *(f32x4*)(o0 + 512 * j) = (a0 - m0) * r0 * gg[2 * j] + bb[2 * j]; *(f32x4*)(o0 + 512 * j + 4) = (a1 - m0) * r0 * gg[2 * j + 1] + bb[2 * j + 1];
            }
            if (t1 != t) {
#pragma unroll
                for (int j = 0; j < 4; ++j) {
                    const f32x4 a0 = (f32x4){(float)z1[j][0], (float)z1[j][1], (float)z1[j][2], (float)z1[j][3]}, a1 = (f32x4){(float)z1[j][4], (float)z1[j][5], (float)z1[j][6], (float)z1[j][7]};
                    *(f32x4*)(o1 + 512 * j) = (a0 - m1) * r1 * gg[2 * j] + bb[2 * j]; *(f32x4*)(o1 + 512 * j + 4) = (a1 - m1) * r1 * gg[2 * j + 1] + bb[2 * j + 1];
                }
            }
        }
    }
}

extern "C" void kernel_launch(void* const* d_in, const int* in_sizes, int n_in, void* d_out, int out_size, void* d_ws, size_t ws_size, hipStream_t stream) {
    static int grid = 0;
    if (grid == 0) {
        if (n_in != 10 || in_sizes[0] != M * D || out_size != M * D || ws_size < WS_END) { fprintf(stderr, "kernel_launch: unexpected shapes (n_in %d, in0 %d, out %d, ws %zu); nothing launched\n", n_in, n_in > 0 ? in_sizes[0] : -1, out_size, ws_size); grid = -1; return; }
        int dev = 0, cus = 0, per_cu = 0;
        hipGetDevice(&dev); hipDeviceGetAttribute(&cus, hipDeviceAttributeMultiprocessorCount, dev);
        if (hipFuncSetAttribute((const void*)hybrid_fwd, hipFuncAttributeMaxDynamicSharedMemorySize, LDS_BYTES) != hipSuccess) { fprintf(stderr, "kernel_launch: hipFuncSetAttribute failed\n"); grid = -1; return; }
        if (hipOccupancyMaxActiveBlocksPerMultiprocessor(&per_cu, (const void*)hybrid_fwd, 512, LDS_BYTES) != hipSuccess || per_cu < 1) { fprintf(stderr, "kernel_launch: occupancy query says %d blocks per CU\n", per_cu); per_cu = 1; }
        (void)hipGetLastError();
        grid = cus * 1;
    }
    if (grid < 0) return;
    Args a{};
    a.x = (const float*)d_in[0]; a.pos = (const int*)d_in[1]; a.w_in = (const float*)d_in[2]; a.b_gate = (const float*)d_in[3]; a.sinks = (const float*)d_in[4];
    a.w_pa = (const float*)d_in[5]; a.w_pb = (const float*)d_in[6]; a.w_out = (const float*)d_in[7]; a.ln_g = (const float*)d_in[8]; a.ln_b = (const float*)d_in[9];
    a.out = (float*)d_out; a.ws = (unsigned char*)d_ws;
    {
        for (int pn = 0; pn < DIN / 256; ++pn) { const bool f8 = true;
            if (f8) { a.tl_fp8[a.n_fp8++] = (unsigned char)pn; a.fp8mask |= 1ull << pn; } else a.tl_bf16[a.n_bf16++] = (unsigned char)pn; }
    }
    for (int j = 0; j < 64; ++j) a.inv_freq[j] = (float)pow(10000.0, -(double)j / 64.0);
    void* args[] = {&a};
    hipError_t e = hipLaunchCooperativeKernel((const void*)hybrid_fwd, dim3(grid), dim3(512), args, LDS_BYTES, stream);
    if (e != hipSuccess) fprintf(stderr, "kernel_launch: cooperative launch failed: %s (grid %d)\n", hipGetErrorString(e), grid);
}
```

```cpp
#include <hip/hip_runtime.h>
#include <hip/hip_cooperative_groups.h>
#include <cstdio>
#include <cstdint>
#include <cmath>
namespace cg = cooperative_groups;

#define LAS __attribute__((address_space(3)))
typedef unsigned short bf16_t;
typedef short bf16x8 __attribute__((ext_vector_type(8)));
typedef short bf16x4 __attribute__((ext_vector_type(4)));
typedef float f32x4 __attribute__((ext_vector_type(4)));
typedef float f32x2 __attribute__((ext_vector_type(2)));
typedef unsigned u32x4 __attribute__((ext_vector_type(4)));
typedef unsigned u32x2 __attribute__((ext_vector_type(2)));

constexpr int M = 16384, D = 2048, DIN = 11520;
constexpr int OFF_QA = 0, OFF_KA = 1024, OFF_VA = 1152, OFF_GA = 1280, OFF_QB = 2304, OFF_KB = 3840, OFF_VB = 5376, OFF_GB = 6912, OFF_MGA = 7424, OFF_MGB = 9472;
constexpr int OFF_UB = 1024;
constexpr float LOG2E = 1.4426950408889634f;
constexpr float SC_QA = 0.125f * LOG2E;
constexpr float SC_QB = 0.08838834764831845f * LOG2E;
constexpr float DN_ALPHA = 1.189207115002721f;
constexpr float LN_EPS = 1e-5f;
constexpr float W8_SCALE = 64.0f;
constexpr float SU8 = 16.0f, SM8 = 32.0f;
constexpr size_t MiB = 1u << 20;
constexpr size_t WS_XB = 0;
constexpr size_t WS_WIN = 64 * MiB;
constexpr size_t WS_WP = 110 * MiB;
constexpr size_t WS_WOUT = 116 * MiB;
constexpr size_t WS_CSB = 124 * MiB;
constexpr size_t WS_CSA = 132 * MiB;
constexpr size_t WS_LSE = 136 * MiB;
constexpr size_t WS_STATS = 137 * MiB;
constexpr size_t WS_CTL = 142 * MiB;
constexpr size_t WS_H = 144 * MiB;
constexpr size_t WS_END = 504 * MiB;
constexpr int LDS_BYTES = 147456;

__device__ __forceinline__ unsigned cvt_pk_bf16(float lo, float hi) { unsigned r; asm volatile("v_cvt_pk_bf16_f32 %0, %1, %2" : "=v"(r) : "v"(lo), "v"(hi)); return r; }
__device__ __forceinline__ float bf_lo(unsigned w) { return __uint_as_float(w << 16); }
__device__ __forceinline__ float bf_hi(unsigned w) { return __uint_as_float(w & 0xffff0000u); }
__device__ __forceinline__ float fast_rcp(float x) { return __builtin_amdgcn_rcpf(x); }
__device__ __forceinline__ float fast_exp2(float x) { return __builtin_amdgcn_exp2f(x); }
__device__ __forceinline__ float sigmoidf_(float v) { return fast_rcp(1.0f + fast_exp2(-v * LOG2E)); }

__device__ __forceinline__ unsigned pack_fp8x4(float a, float b, float c, float d) {
    const unsigned lo = (unsigned)__builtin_amdgcn_cvt_pk_fp8_f32(a, b, 0, false), hi = (unsigned)__builtin_amdgcn_cvt_pk_fp8_f32(c, d, 0, false);
    return (lo & 0xffffu) | (hi << 16);
}

__device__ __forceinline__ void unpack_fp8x8(u32x2 w, f32x4& lo, f32x4& hi) {
    typedef float f2 __attribute__((ext_vector_type(2)));
    const f2 a = __builtin_amdgcn_cvt_pk_f32_fp8((int)w.x, false), b = __builtin_amdgcn_cvt_pk_f32_fp8((int)w.x, true), c = __builtin_amdgcn_cvt_pk_f32_fp8((int)w.y, false), d = __builtin_amdgcn_cvt_pk_f32_fp8((int)w.y, true);
    lo = (f32x4){a[0], a[1], b[0], b[1]}; hi = (f32x4){c[0], c[1], d[0], d[1]};
}

namespace pg8 {
constexpr int BM = 256, BK = 64, HALF = 128, HTB = HALF * BK * 2, STAGE_BYTES = 8 * HTB, NXCD = 8, WGM = 2;
__host__ __device__ __forceinline__ int lds_byte(int r, int c) { const int st = (r >> 4) * 2 + (c >> 5), rr = r & 15, cc = c & 31, ob = rr * 64 + cc * 2; return st * 1024 + (ob ^ (((ob >> 9) & 1) << 5)); }
__host__ __device__ __forceinline__ void stage_rc(int b, int& R, int& C) { const int st = b / 1024, sb = b % 1024, swz = sb ^ (((sb >> 9) & 1) << 5); R = (st >> 1) * 16 + swz / 64; C = (st & 1) * 32 + (swz % 64) / 2; }
__host__ __device__ __forceinline__ int perm32(int rho) { const int n = rho >> 4, i = rho & 15; return 8 * (i >> 2) + 4 * n + (i & 3); }

typedef int v8i_t __attribute__((ext_vector_type(8))); typedef int v4i_t __attribute__((ext_vector_type(4)));
__device__ __forceinline__ v8i_t join8(bf16x8 lo, bf16x8 hi) { const v4i_t a = __builtin_bit_cast(v4i_t, lo), b = __builtin_bit_cast(v4i_t, hi); return __builtin_shufflevector(a, b, 0, 1, 2, 3, 4, 5, 6, 7); }
struct Unit { int pm, pn, k0, nt, part; };
struct Gemm { const bf16_t* A; const bf16_t* Bt; int lda, ldb; };

__device__ __forceinline__ void tile_of(int L, int nM, int nN, int& pm, int& pn) {
    const int nwg = nM * nN; int wgid = L;
    { const int q = nwg / NXCD, r = nwg % NXCD, xcd = wgid % NXCD, off = wgid / NXCD; wgid = (xcd < r ? xcd * (q + 1) : r * (q + 1) + (xcd - r) * q) + off; }
    const int nig = WGM * nN, gid = wgid / nig, fm = gid * WGM, gsz = (nM - fm) < WGM ? (nM - fm) : WGM;
    pm = fm + ((wgid % nig) % gsz); pn = (wgid % nig) / gsz;
}
struct OrderPlain {
    int nM, nN, nwg, G, c, nt;
    __device__ __forceinline__ bool next(int i, Unit& u) const { const long L = (long)i * G + c; if (L >= nwg) return false; tile_of((int)L, nM, nN, u.pm, u.pn); u.k0 = 0; u.nt = nt; u.part = 0; return true; }
};
struct OrderList {
    int nM, nN, nwg, G, c, nt; const unsigned char* list;
    __device__ __forceinline__ bool next(int i, Unit& u) const { const long L = (long)i * G + c; if (L >= nwg) return false; int j; tile_of((int)L, nM, nN, u.pm, j); u.pn = list[j]; u.k0 = 0; u.nt = nt; u.part = 0; return true; }
};
struct OrderTwoPart {
    int nM, nN, nwg, G, c, k1, nt0, nt1;
    __device__ __forceinline__ bool next(int i, Unit& u) const { const long L = (long)(i >> 1) * G + c; if (L >= nwg) return false; tile_of((int)L, nM, nN, u.pm, u.pn);
        u.part = i & 1; u.k0 = u.part ? k1 : 0; u.nt = u.part ? nt1 : nt0; return true; }
};

template <class Epi, class Sched, bool FP8 = false>
__device__ __forceinline__ void gemm_phase(LAS unsigned char* lds, const Gemm g, const Sched& S, const Epi& E) {
    const int tid = threadIdx.x;
    const int wid = __builtin_amdgcn_readfirstlane(tid >> 6), lane = tid & 63, wr = wid >> 2, wc = wid & 3, fr = lane & 15, fq = lane >> 4;
    unsigned voffA[2], voffB[2];
#pragma unroll
    for (int i = 0; i < 2; ++i) { int R, C; stage_rc(tid * 16 + i * 8192, R, C); const int Rb = Epi::PERM ? ((R & ~31) + perm32(R & 31)) : R;
        voffA[i] = (unsigned)(R * g.lda + C) * 2u; voffB[i] = (unsigned)(Rb * g.ldb + C) * 2u; }
    const size_t kstep = (size_t)(BK * 2);
    const size_t hstepA = (size_t)HALF * g.lda * 2, hstepB = (size_t)HALF * g.ldb * 2;
    const size_t tstepA = 2 * hstepA, tstepB = 2 * hstepB;
    const unsigned ldsw = (unsigned)wid * 1024u;
    const int aoff = lds_byte(wr * 64 + fr, fq * 8), boff = lds_byte(wc * 32 + fr, fq * 8);
#define PG8_SA(b, h) (((b) * 2 + (h)) * HTB)
#define PG8_SB(b, h) ((4 + (b) * 2 + (h)) * HTB)
#define PG8_STAGE(bufoff, gbase, voff) do { _Pragma("unroll") for (int _i = 0; _i < 2; ++_i) \
        __builtin_amdgcn_global_load_lds((const unsigned*)((const char*)(gbase) + (voff)[_i]), (LAS unsigned*)(lds + (bufoff) + ldsw + _i * 8192), 16, 0, 0); } while (0)
#define PG8_LDA(dst, b, h) do { _Pragma("unroll") for (int m = 0; m < 4; ++m) { \
        if constexpr (FP8) dst##8[m] = join8(*(const LAS bf16x8*)(lds + PG8_SA(b, h) + aoff + m * 2048), *(const LAS bf16x8*)(lds + PG8_SA(b, h) + aoff + m * 2048 + 1024)); \
        else { _Pragma("unroll") for (int k = 0; k < 2; ++k) dst[m][k] = *(const LAS bf16x8*)(lds + PG8_SA(b, h) + aoff + m * 2048 + k * 1024); } } } while (0)
#define PG8_LDB(dst, b, h) do { _Pragma("unroll") for (int n = 0; n < 2; ++n) { \
        if constexpr (FP8) dst##8[n] = join8(*(const LAS bf16x8*)(lds + PG8_SB(b, h) + boff + n * 2048), *(const LAS bf16x8*)(lds + PG8_SB(b, h) + boff + n * 2048 + 1024)); \
        else { _Pragma("unroll") for (int k = 0; k < 2; ++k) dst[n][k] = *(const LAS bf16x8*)(lds + PG8_SB(b, h) + boff + n * 2048 + k * 1024); } } } while (0)
#define PG8_MMA(ai, bj, At, Bt) do { __builtin_amdgcn_s_setprio(1); \
        if constexpr (FP8) { _Pragma("unroll") for (int m = 0; m < 4; ++m) _Pragma("unroll") for (int n = 0; n < 2; ++n) \
            asm volatile("v_mfma_scale_f32_16x16x128_f8f6f4 %0, %1, %2, %0, %3, %3 op_sel_hi:[0,0,0]" : "+v"(acc[ai][bj][m][n]) : "v"(Bt##8[n]), "v"(At##8[m]), "v"(fp8_one)); } \
        else { _Pragma("unroll") for (int m = 0; m < 4; ++m) _Pragma("unroll") for (int n = 0; n < 2; ++n) _Pragma("unroll") for (int k = 0; k < 2; ++k) \
            acc[ai][bj][m][n] = __builtin_amdgcn_mfma_f32_16x16x32_bf16(Bt[n][k], At[m][k], acc[ai][bj][m][n], 0, 0, 0); } \
        __builtin_amdgcn_s_setprio(0); } while (0)
#define PG8_WAIT_V(n) asm volatile("s_waitcnt vmcnt(" #n ")" ::: "memory")
#define PG8_WAIT_L(n) asm volatile("s_waitcnt lgkmcnt(" #n ")" ::: "memory")
#define PG8_BAR __builtin_amdgcn_s_barrier()
#define PG8_SCHED __builtin_amdgcn_sched_barrier(0)
    Unit cur, nxt; int ui = 0;
    if (!S.next(0, cur)) return;
    f32x4 acc[2][2][4][2];
#pragma unroll
    for (int a = 0; a < 2; ++a)
#pragma unroll
        for (int b = 0; b < 2; ++b)
#pragma unroll
            for (int m = 0; m < 4; ++m)
#pragma unroll
                for (int n = 0; n < 2; ++n) acc[a][b][m][n] = (f32x4){0.f, 0.f, 0.f, 0.f};
    const int fp8_one = 0x7F7F7F7F;
    bf16x8 At[4][2], B0[2][2], B1[2][2]; v8i_t At8[4], B08[2], B18[2];
    const char* cA = (const char*)g.A + (size_t)cur.pm * tstepA + (size_t)cur.k0 * 2; const char* cB = (const char*)g.Bt + (size_t)cur.pn * tstepB + (size_t)cur.k0 * 2;
    PG8_STAGE(PG8_SB(0, 0), cB, voffB); PG8_STAGE(PG8_SB(0, 1), cB + hstepB, voffB); PG8_STAGE(PG8_SA(0, 0), cA, voffA); PG8_STAGE(PG8_SA(0, 1), cA + hstepA, voffA);
    if (wr == 1) PG8_BAR;
    PG8_WAIT_V(2); PG8_BAR;
    PG8_STAGE(PG8_SB(1, 0), cB + kstep, voffB); PG8_STAGE(PG8_SA(1, 0), cA + kstep, voffA); PG8_STAGE(PG8_SB(1, 1), cB + hstepB + kstep, voffB);
    PG8_WAIT_V(6); PG8_BAR;
    for (;;) {
        const bool has_next = S.next(ui + 1, nxt);
        const char* nA = has_next ? (const char*)g.A + (size_t)nxt.pm * tstepA + (size_t)nxt.k0 * 2 : cA; const char* nB = has_next ? (const char*)g.Bt + (size_t)nxt.pn * tstepB + (size_t)nxt.k0 * 2 : cB;
        const int nt = cur.nt;
        for (int t = 0; t < nt; t += 2) {
            const bool last = (t == nt - 2);
            const char* a1 = cA + (size_t)(t + 1) * kstep;
            const char* a2 = last ? nA : cA + (size_t)(t + 2) * kstep; const char* b2 = last ? nB : cB + (size_t)(t + 2) * kstep;
            const char* a3 = a2 + kstep; const char* b3 = b2 + kstep;
            PG8_LDB(B0, 0, 0); PG8_LDB(B1, 0, 1); PG8_SCHED; PG8_LDA(At, 0, 0); PG8_STAGE(PG8_SA(1, 1), a1 + hstepA, voffA);
            PG8_WAIT_V(8); PG8_WAIT_L(0); PG8_BAR; PG8_MMA(0, 0, At, B0); PG8_MMA(0, 1, At, B1); PG8_BAR; PG8_SCHED;
            PG8_LDA(At, 0, 1); PG8_STAGE(PG8_SB(0, 0), b2, voffB); PG8_STAGE(PG8_SB(0, 1), b2 + hstepB, voffB); PG8_STAGE(PG8_SA(0, 0), a2, voffA);
            PG8_WAIT_V(8); PG8_WAIT_L(0); PG8_BAR; PG8_MMA(1, 0, At, B0); PG8_MMA(1, 1, At, B1); PG8_BAR; PG8_SCHED;
            PG8_LDB(B0, 1, 0); PG8_LDB(B1, 1, 1); PG8_SCHED; PG8_LDA(At, 1, 0); PG8_STAGE(PG8_SA(0, 1), a2 + hstepA, voffA);
            PG8_WAIT_V(8); PG8_WAIT_L(0); PG8_BAR; PG8_MMA(0, 0, At, B0); PG8_MMA(0, 1, At, B1); PG8_BAR; PG8_SCHED;
            PG8_LDA(At, 1, 1); PG8_STAGE(PG8_SB(1, 0), b3, voffB); PG8_STAGE(PG8_SB(1, 1), b3 + hstepB, voffB); PG8_STAGE(PG8_SA(1, 0), a3, voffA);
            PG8_WAIT_V(8); PG8_WAIT_L(0); PG8_BAR; PG8_MMA(1, 0, At, B0); PG8_MMA(1, 1, At, B1); PG8_BAR; PG8_SCHED;
        }
        if (wr == 0) PG8_BAR;
        if constexpr (FP8) asm volatile("s_nop 15\n\ts_nop 15" ::: "memory");
        E(acc, cur, wr, wc, fr, fq);
        if (!has_next) break;
        if (!E.keep(cur)) {
#pragma unroll
            for (int a = 0; a < 2; ++a)
#pragma unroll
                for (int b = 0; b < 2; ++b)
#pragma unroll
                    for (int m = 0; m < 4; ++m)
#pragma unroll
                        for (int n = 0; n < 2; ++n) acc[a][b][m][n] = (f32x4){0.f, 0.f, 0.f, 0.f};
        }
        cur = nxt; cA = nA; cB = nB; ++ui;
        if (wr == 1) PG8_BAR;
    }
    PG8_WAIT_V(0);
    PG8_BAR;
#undef PG8_SA
#undef PG8_SB
#undef PG8_STAGE
#undef PG8_LDA
#undef PG8_LDB
#undef PG8_MMA
#undef PG8_WAIT_V
#undef PG8_WAIT_L
#undef PG8_BAR
#undef PG8_SCHED
}
}

__host__ __device__ __forceinline__ int tile_mode(int pn) { return (pn <= 4) ? 1 : (pn >= 9 && pn <= 20) ? 2 : 0; }
__host__ __device__ __forceinline__ int gemm_col_to_orig(int nprime) {
    const int pn = nprime >> 8, xp = nprime & 255, bj = xp >> 7, x = xp & 127, md = tile_mode(pn);
    if (md == 1) return 256 * pn + 64 * (x >> 5) + (x & 31) + 32 * bj;
    if (md == 2) return 256 * pn + 128 * (x >> 6) + (x & 63) + 64 * bj;
    return nprime;
}

struct Epi1 {
    static constexpr bool PERM = true;
    bf16_t* H; const f32x2* csA; const f32x2* csB; const float* bgate; int pn_off; float ascale;
    __device__ __forceinline__ bool keep(const pg8::Unit&) const { return false; }
    __device__ __forceinline__ void operator()(f32x4 (&acc)[2][2][4][2], const pg8::Unit& u, int wr, int wc, int fr, int fq) const {
        const int pn = u.pn + pn_off, md = tile_mode(pn);
        const int row0 = u.pm * 256 + wr * 64 + fr;
        int col0, cstep;
        if (md == 1) { col0 = 256 * pn + 64 * wc + 8 * fq; cstep = 32; }
        else if (md == 2) { col0 = 256 * pn + 128 * (wc >> 1) + 32 * (wc & 1) + 8 * fq; cstep = 64; }
        else { col0 = 256 * pn + 32 * wc + 8 * fq; cstep = 128; }
        const bool rope = (md == 2) || (md == 1 && (pn < 4 || wc < 2));
        if (rope) {
            const float sc = ((pn < 4) ? SC_QA : (pn >= 9 && pn < 15) ? SC_QB : 1.0f) * ascale;
#pragma unroll
            for (int ai = 0; ai < 2; ++ai)
#pragma unroll
                for (int m = 0; m < 4; ++m) {
                    const int row = row0 + ai * 128 + m * 16;
                    const f32x4* cp = (md == 1) ? (const f32x4*)(csA + (size_t)row * 32 + 8 * fq) : (const f32x4*)(csB + (size_t)row * 64 + 32 * (wc & 1) + 8 * fq);
                    const f32x4 t0 = cp[0], t1 = cp[1], t2 = cp[2], t3 = cp[3];
                    const f32x4 a0 = acc[ai][0][m][0], a1 = acc[ai][0][m][1], b0 = acc[ai][1][m][0], b1 = acc[ai][1][m][1];
                    u32x4 w0, w1;
                    w0.x = cvt_pk_bf16((a0[0] * t0[0] - b0[0] * t0[1]) * sc, (a0[1] * t0[2] - b0[1] * t0[3]) * sc);
                    w0.y = cvt_pk_bf16((a0[2] * t1[0] - b0[2] * t1[1]) * sc, (a0[3] * t1[2] - b0[3] * t1[3]) * sc);
                    w0.z = cvt_pk_bf16((a1[0] * t2[0] - b1[0] * t2[1]) * sc, (a1[1] * t2[2] - b1[1] * t2[3]) * sc);
                    w0.w = cvt_pk_bf16((a1[2] * t3[0] - b1[2] * t3[1]) * sc, (a1[3] * t3[2] - b1[3] * t3[3]) * sc);
                    w1.x = cvt_pk_bf16((b0[0] * t0[0] + a0[0] * t0[1]) * sc, (b0[1] * t0[2] + a0[1] * t0[3]) * sc);
                    w1.y = cvt_pk_bf16((b0[2] * t1[0] + a0[2] * t1[1]) * sc, (b0[3] * t1[2] + a0[3] * t1[3]) * sc);
                    w1.z = cvt_pk_bf16((b1[0] * t2[0] + a1[0] * t2[1]) * sc, (b1[1] * t2[2] + a1[1] * t2[3]) * sc);
                    w1.w = cvt_pk_bf16((b1[2] * t3[0] + a1[2] * t3[1]) * sc, (b1[3] * t3[2] + a1[3] * t3[3]) * sc);
                    bf16_t* rp = H + (size_t)row * DIN + col0;
                    *(u32x4*)(rp) = w0; *(u32x4*)(rp + cstep) = w1;
                    if (m == 3) asm volatile("" ::: "memory");
                }
        } else {
            const int act = (pn >= 29) ? 2 : ((pn >= 5 && pn <= 8) || pn == 27 || pn == 28) ? 1 : 0;
            f32x4 bv[2][2];
#pragma unroll
            for (int bj = 0; bj < 2; ++bj)
#pragma unroll
                for (int n = 0; n < 2; ++n) bv[bj][n] = (act == 2) ? *(const f32x4*)(bgate + (col0 + bj * cstep - OFF_MGA) + 4 * n) : (f32x4){0.f, 0.f, 0.f, 0.f};
#pragma unroll
            for (int ai = 0; ai < 2; ++ai)
#pragma unroll
                for (int m = 0; m < 4; ++m) {
                    bf16_t* rp = H + (size_t)(row0 + ai * 128 + m * 16) * DIN + col0;
#pragma unroll
                    for (int bj = 0; bj < 2; ++bj) {
                        f32x4 v0 = acc[ai][bj][m][0] * ascale + bv[bj][0], v1 = acc[ai][bj][m][1] * ascale + bv[bj][1];
                        if (act == 1) {
#pragma unroll
                            for (int j = 0; j < 4; ++j) { v0[j] = v0[j] * sigmoidf_(v0[j]); v1[j] = v1[j] * sigmoidf_(v1[j]); } }
                        else if (act == 2) {
#pragma unroll
                            for (int j = 0; j < 4; ++j) { v0[j] = sigmoidf_(v0[j]); v1[j] = sigmoidf_(v1[j]); } }
                        if (act != 0) {
                            const int offx = (pn >= 37) ? OFF_MGB : (pn >= 29) ? OFF_MGA : (pn >= 27) ? OFF_GB : OFF_GA;
                            unsigned char* gp = (unsigned char*)(H + (size_t)(row0 + ai * 128 + m * 16) * DIN + offx) + (col0 + bj * cstep - offx);
                            *(u32x2*)gp = (u32x2){pack_fp8x4(v0[0], v0[1], v0[2], v0[3]), pack_fp8x4(v1[0], v1[1], v1[2], v1[3])};
                        } else {
                        u32x4 w; w.x = cvt_pk_bf16(v0[0], v0[1]); w.y = cvt_pk_bf16(v0[2], v0[3]); w.z = cvt_pk_bf16(v1[0], v1[1]); w.w = cvt_pk_bf16(v1[2], v1[3]);
                        *(u32x4*)(rp + bj * cstep) = w; }
                    }
                }
        }
    }
};

struct Epi2 {
    static constexpr bool PERM = true;
    const bf16_t* H; unsigned char* MG8; float oscale;
    __device__ __forceinline__ bool keep(const pg8::Unit& u) const { return u.part == 0; }
    __device__ __forceinline__ void operator()(f32x4 (&acc)[2][2][4][2], const pg8::Unit& u, int wr, int wc, int fr, int fq) const {
        const int row0 = u.pm * 256 + wr * 64 + fr, col0 = u.pn * 256 + wc * 32 + 8 * fq;
        if (u.part == 0) {
#pragma unroll
            for (int ai = 0; ai < 2; ++ai)
#pragma unroll
                for (int m = 0; m < 4; ++m) {
                    const bf16_t* hrow = H + (size_t)(row0 + ai * 128 + m * 16) * DIN;
#pragma unroll
                    for (int bj = 0; bj < 2; ++bj) {
                        const u32x2 sa = *(const u32x2*)((const unsigned char*)(hrow + OFF_MGA) + col0 + bj * 128), sb = *(const u32x2*)((const unsigned char*)(hrow + OFF_MGB) + col0 + bj * 128);
                        f32x4 a0, a1, b0, b1; unpack_fp8x8(sa, a0, a1); unpack_fp8x8(sb, b0, b1);
                        f32x4 r0, r1;
#pragma unroll
                        for (int e = 0; e < 4; ++e) { r0[e] = a0[e] * fast_rcp(fmaxf(b0[e], 1e-30f)); r1[e] = a1[e] * fast_rcp(fmaxf(b1[e], 1e-30f)); }
                        acc[ai][bj][m][0] *= r0; acc[ai][bj][m][1] *= r1;
                    }
                    if (m == 3) asm volatile("" ::: "memory");
                }
        } else {
#pragma unroll
            for (int ai = 0; ai < 2; ++ai)
#pragma unroll
                for (int m = 0; m < 4; ++m) {
                    const size_t rr = (size_t)(row0 + ai * 128 + m * 16);
                    const bf16_t* hrow = H + rr * DIN; unsigned char* op = MG8 + rr * D + col0;
#pragma unroll
                    for (int bj = 0; bj < 2; ++bj) {
                        const u32x2 sbw = *(const u32x2*)((const unsigned char*)(hrow + OFF_MGB) + col0 + bj * 128);
                        f32x4 b0, b1; unpack_fp8x8(sbw, b0, b1);
                        const f32x4 v0 = acc[ai][bj][m][0] * oscale * b0, v1 = acc[ai][bj][m][1] * oscale * b1;
                        const unsigned p0 = pack_fp8x4(v0[0], v0[1], v0[2], v0[3]), p1 = pack_fp8x4(v1[0], v1[1], v1[2], v1[3]);
                        *(u32x2*)(op + bj * 128) = (u32x2){p0, p1};
                    }
                    if (m == 3) asm volatile("" ::: "memory");
                }
        }
    }
};

struct Epi3 {
    static constexpr bool PERM = false;
    const float* x; _Float16* z16; f32x2* stats; float ascale;
    __device__ __forceinline__ bool keep(const pg8::Unit&) const { return false; }
    __device__ __forceinline__ void operator()(f32x4 (&acc)[2][2][4][2], const pg8::Unit& u, int wr, int wc, int fr, int fq) const {
        const int row0 = u.pm * 256 + wr * 64 + fr, col0 = u.pn * 256 + wc * 32 + 4 * fq;
#pragma unroll
        for (int ai = 0; ai < 2; ++ai)
#pragma unroll
            for (int m = 0; m < 4; ++m) {
                const int row = row0 + ai * 128 + m * 16; const size_t off = (size_t)row * D + col0;
                float s = 0.f, q = 0.f;
#pragma unroll
                for (int bj = 0; bj < 2; ++bj)
#pragma unroll
                    for (int n = 0; n < 2; ++n) {
                        const f32x4 xv = *(const f32x4*)(x + off + bj * 128 + n * 16);
                        const f32x4 z = xv * DN_ALPHA + acc[ai][bj][m][n] * ascale;
                        { typedef _Float16 h4 __attribute__((ext_vector_type(4))); *(h4*)(z16 + off + bj * 128 + n * 16) = (h4){(_Float16)z[0], (_Float16)z[1], (_Float16)z[2], (_Float16)z[3]}; }
                        s += (z[0] + z[1]) + (z[2] + z[3]); q += (z[0] * z[0] + z[1] * z[1]) + (z[2] * z[2] + z[3] * z[3]);
                    }
                s += __shfl_xor(s, 16); s += __shfl_xor(s, 32); q += __shfl_xor(q, 16); q += __shfl_xor(q, 32);
                if (fq == 0) stats[(size_t)row * 32 + u.pn * 4 + wc] = (f32x2){s, q};
                asm volatile("" ::: "memory");
            }
    }
};

__device__ __forceinline__ void transpose_item(const float* W, int N, bf16_t* WT, int ldt, int k0, int n_src, int n_dst, int kofs, LAS float* scr, int lane) {
    const int r8 = lane >> 3, c4 = lane & 7;
    f32x4 v[8];
#pragma unroll
    for (int i = 0; i < 8; ++i) v[i] = *(const f32x4*)(W + (size_t)(k0 + r8 + 8 * i) * N + n_src + 4 * c4);
#pragma unroll
    for (int i = 0; i < 8; ++i) { LAS float* d = scr + (r8 + 8 * i) * 33 + 4 * c4; d[0] = v[i][0]; d[1] = v[i][1]; d[2] = v[i][2]; d[3] = v[i][3]; }
    asm volatile("s_waitcnt lgkmcnt(0)" ::: "memory");
    const int c = lane & 7;
#pragma unroll
    for (int j = 0; j < 4; ++j) { const int n = (lane >> 3) + 8 * j; const LAS float* s = scr + (8 * c) * 33 + n;
        u32x4 o; o.x = cvt_pk_bf16(s[0 * 33], s[1 * 33]); o.y = cvt_pk_bf16(s[2 * 33], s[3 * 33]); o.z = cvt_pk_bf16(s[4 * 33], s[5 * 33]); o.w = cvt_pk_bf16(s[6 * 33], s[7 * 33]);
        *(u32x4*)(WT + (size_t)(n_dst + n) * ldt + kofs + k0 + 8 * c) = o; }
    asm volatile("s_waitcnt lgkmcnt(0)" ::: "memory");
}

__device__ __forceinline__ void transpose_item_fp8(const float* W, int N, unsigned char* W8, int pitch, int kofs, int k0, int n_src, int n_dst, float scale, LAS float* scr, int lane) {
    const int r8 = lane >> 3, c4 = lane & 7;
    f32x4 v[8];
#pragma unroll
    for (int i = 0; i < 8; ++i) v[i] = *(const f32x4*)(W + (size_t)(k0 + r8 + 8 * i) * N + n_src + 4 * c4);
#pragma unroll
    for (int i = 0; i < 8; ++i) { LAS float* d = scr + (r8 + 8 * i) * 33 + 4 * c4; d[0] = v[i][0]; d[1] = v[i][1]; d[2] = v[i][2]; d[3] = v[i][3]; }
    asm volatile("s_waitcnt lgkmcnt(0)" ::: "memory");
    const int n = lane & 31, cp = lane >> 5;
#pragma unroll
    for (int q = 0; q < 2; ++q) { const int ck = (2 * cp + q) * 16; const LAS float* sp = scr + ck * 33 + n; u32x4 o;
#pragma unroll
        for (int w = 0; w < 4; ++w) o[w] = pack_fp8x4(sp[(4 * w) * 33] * scale, sp[(4 * w + 1) * 33] * scale, sp[(4 * w + 2) * 33] * scale, sp[(4 * w + 3) * 33] * scale);
        *(u32x4*)(W8 + (size_t)(n_dst + n) * pitch + kofs + k0 + ck) = o; }
    asm volatile("s_waitcnt lgkmcnt(0)" ::: "memory");
}

template <int DH, bool IS_A>
__device__ __forceinline__ void attn_task(const LAS unsigned char* Kl, const LAS unsigned char* Vl, const bf16x8 (&qf)[DH / 32], const u32x2 (&gwv)[DH / 16], bf16_t* orow,
                                          int i0, int jlo, float sink2, float* lse_ptr, int lane, unsigned char* u8row) {
    constexpr int KS = (DH == 128) ? 288 : 160, VS = (DH == 128) ? 288 : 160, NKS = DH / 32, NDT = DH / 16;
    const int c16 = lane & 15, g = lane >> 4;
    f32x4 s[9];
    const LAS unsigned char* kp = Kl + (i0 + c16) * KS + 16 * g;
    bf16x8 kf[2][9];
#pragma unroll
    for (int T = 0; T < 9; ++T) { s[T] = (f32x4){0.f, 0.f, 0.f, 0.f}; kf[0][T] = *(const LAS bf16x8*)(kp + T * 16 * KS); }
#pragma unroll
    for (int ks = 0; ks < NKS; ++ks) {
        if (ks + 1 < NKS) {
#pragma unroll
            for (int T = 0; T < 9; ++T) kf[(ks + 1) & 1][T] = *(const LAS bf16x8*)(kp + T * 16 * KS + (ks + 1) * 64); }
        __builtin_amdgcn_sched_barrier(0);
#pragma unroll
        for (int T = 0; T < 9; ++T) s[T] = __builtin_amdgcn_mfma_f32_16x16x32_bf16(kf[ks & 1][T], qf[ks], s[T], 0, 0, 0);
        __builtin_amdgcn_sched_barrier(0);
    }
    const int i = i0 + c16; const int jmin = max(i + (IS_A ? 1 : 0), jlo), jmax = i + 128;
    float mx = -INFINITY;
#pragma unroll
    for (int T = 0; T < 9; ++T)
#pragma unroll
        for (int r = 0; r < 4; ++r) { const int j = i0 + 16 * T + 4 * g + r; const bool ok = (j >= jmin) && (j <= jmax); const float v = ok ? s[T][r] : -INFINITY; s[T][r] = v; mx = fmaxf(mx, v); }
    mx = fmaxf(mx, __shfl_xor(mx, 16)); mx = fmaxf(mx, __shfl_xor(mx, 32));
    if (IS_A) mx = fmaxf(mx, sink2);
    float sum = 0.f;
#pragma unroll
    for (int T = 0; T < 9; ++T)
#pragma unroll
        for (int r = 0; r < 4; ++r) { const float p = fast_exp2(s[T][r] - mx); s[T][r] = p; sum += p; }
    sum += __shfl_xor(sum, 16); sum += __shfl_xor(sum, 32);
    if (IS_A) sum += fast_exp2(sink2 - mx);
    bf16x8 pf[4];
#pragma unroll
    for (int k = 0; k < 4; ++k) { u32x4 w; w.x = cvt_pk_bf16(s[2 * k][0], s[2 * k][1]); w.y = cvt_pk_bf16(s[2 * k][2], s[2 * k][3]); w.z = cvt_pk_bf16(s[2 * k + 1][0], s[2 * k + 1][1]); w.w = cvt_pk_bf16(s[2 * k + 1][2], s[2 * k + 1][3]);
        pf[k] = __builtin_bit_cast(bf16x8, w); }
    bf16x4 p8; { u32x2 w; w.x = cvt_pk_bf16(s[8][0], s[8][1]); w.y = cvt_pk_bf16(s[8][2], s[8][3]); p8 = __builtin_bit_cast(bf16x4, w); }
    const int q4 = c16 >> 2, p4 = c16 & 3;
    const LAS unsigned char* vp = Vl + (i0 + 4 * g + q4) * VS + 8 * p4;
    const float inv = fast_rcp(sum);
    bf16x4 vv[2][9];
#pragma unroll
    for (int r9 = 0; r9 < 9; ++r9) vv[0][r9] = __builtin_amdgcn_ds_read_tr16_b64_v4i16((LAS bf16x4*)(vp + (16 * r9) * VS));
#pragma unroll
    for (int dt = 0; dt < NDT; ++dt) {
        if (dt + 1 < NDT) {
#pragma unroll
            for (int r9 = 0; r9 < 9; ++r9) vv[(dt + 1) & 1][r9] = __builtin_amdgcn_ds_read_tr16_b64_v4i16((LAS bf16x4*)(vp + (16 * r9) * VS + (dt + 1) * 32)); }
        __builtin_amdgcn_sched_barrier(0);
        f32x4 o = (f32x4){0.f, 0.f, 0.f, 0.f};
#pragma unroll
        for (int k = 0; k < 4; ++k) {
            const bf16x4 lo = vv[dt & 1][2 * k], hi = vv[dt & 1][2 * k + 1];
            o = __builtin_amdgcn_mfma_f32_16x16x32_bf16((bf16x8){lo[0], lo[1], lo[2], lo[3], hi[0], hi[1], hi[2], hi[3]}, pf[k], o, 0, 0, 0);
        }
        { const bf16x4 l8 = vv[dt & 1][8];
          o = __builtin_amdgcn_mfma_f32_16x16x32_bf16((bf16x8){l8[0], l8[1], l8[2], l8[3], l8[0], l8[1], l8[2], l8[3]}, (bf16x8){p8[0], p8[1], p8[2], p8[3], 0, 0, 0, 0}, o, 0, 0, 0); }
        __builtin_amdgcn_sched_barrier(0);
        o = o * inv;
        if (IS_A) { typedef float f2 __attribute__((ext_vector_type(2))); const f2 ga = __builtin_amdgcn_cvt_pk_f32_fp8((int)gwv[dt].x, false), gb = __builtin_amdgcn_cvt_pk_f32_fp8((int)gwv[dt].x, true);
            o[0] *= ga[0] * SU8; o[1] *= ga[1] * SU8; o[2] *= gb[0] * SU8; o[3] *= gb[1] * SU8;
            *(unsigned*)(u8row + 16 * dt + 4 * g) = pack_fp8x4(o[0], o[1], o[2], o[3]); }
        else *(unsigned*)((unsigned char*)orow + 16 * dt + 4 * g) = pack_fp8x4(o[0] * SU8, o[1] * SU8, o[2] * SU8, o[3] * SU8);
    }
    if (!IS_A) { if (g == 0) *lse_ptr = mx + __builtin_amdgcn_logf(sum); }
}

template <int DH>
__device__ __forceinline__ void load_kv(LAS unsigned char* Kl, LAS unsigned char* Vl, const bf16_t* Hk, const bf16_t* Hv, long tok0, int tstride, int jlo, int tid) {
    constexpr int KS = (DH == 128) ? 288 : 160, VS = (DH == 128) ? 288 : 160, CPR = DH / 8, PER = 256 * CPR / 512;
    u32x4 kv[PER], vv[PER];
#pragma unroll
    for (int c = 0; c < PER; ++c) { const int idx = c * 512 + tid, row = idx / CPR, ch = idx % CPR;
        if (row >= jlo) { const size_t off = (size_t)(tok0 + (long)row * tstride) * DIN + ch * 8; kv[c] = *(const u32x4*)(Hk + off); vv[c] = *(const u32x4*)(Hv + off); }
        else { kv[c] = (u32x4){0u, 0u, 0u, 0u}; vv[c] = (u32x4){0u, 0u, 0u, 0u}; } }
#pragma unroll
    for (int c = 0; c < PER; ++c) { const int idx = c * 512 + tid, row = idx / CPR, ch = idx % CPR;
        *(LAS u32x4*)(Kl + row * KS + ch * 16) = kv[c]; *(LAS u32x4*)(Vl + row * VS + ch * 16) = vv[c]; }
}


__device__ __forceinline__ void own_barrier(unsigned* cnt, unsigned G) {
    asm volatile("s_waitcnt vmcnt(0) lgkmcnt(0)" ::: "memory");
    __syncthreads();
    if (threadIdx.x == 0) {
        __builtin_amdgcn_fence(__ATOMIC_RELEASE, "agent"); asm volatile("s_waitcnt vmcnt(0)" ::: "memory");
        unsigned target;
        if ((G & 7u) == 0u) { target = 8u;
            const unsigned old = __hip_atomic_fetch_add(cnt + 64 * (1 + (blockIdx.x & 7)), 1u, __ATOMIC_RELAXED, __HIP_MEMORY_SCOPE_AGENT);
            if (old + 1u == (G >> 3)) __hip_atomic_fetch_add(cnt, 1u, __ATOMIC_RELAXED, __HIP_MEMORY_SCOPE_AGENT); }
        else { target = G; __hip_atomic_fetch_add(cnt, 1u, __ATOMIC_RELAXED, __HIP_MEMORY_SCOPE_AGENT); }
        unsigned spins = 0;
        while (__hip_atomic_load(cnt, __ATOMIC_RELAXED, __HIP_MEMORY_SCOPE_AGENT) < target && ++spins < (1u << 22)) __builtin_amdgcn_s_sleep(1);
        __builtin_amdgcn_fence(__ATOMIC_ACQUIRE, "agent"); asm volatile("s_waitcnt vmcnt(0)" ::: "memory");
    }
    __syncthreads();
}
#define GRID_SYNC() do { if (seam_no == 0) { asm volatile("s_waitcnt vmcnt(0) lgkmcnt(0)" ::: "memory"); grid.sync(); } else own_barrier((unsigned*)(ws + WS_CTL) + 1024 * seam_no, (unsigned)G); ++seam_no; } while (0)
struct Args {
    const float* x; const int* pos; const float* w_in; const float* b_gate; const float* sinks; const float* w_pa; const float* w_pb; const float* w_out; const float* ln_g; const float* ln_b;
    float* out; unsigned char* ws;
    float inv_freq[64];
    unsigned char tl_bf16[48], tl_fp8[48];
    int n_bf16, n_fp8; unsigned long long fp8mask;
};

__global__ void __launch_bounds__(512, 2) hybrid_fwd(Args a) {
    extern __shared__ __attribute__((aligned(16))) unsigned char lds_raw[];
    LAS unsigned char* lds = (LAS unsigned char*)lds_raw;
    cg::grid_group grid = cg::this_grid();
    int tid = threadIdx.x, lane = tid & 63; const int wave = __builtin_amdgcn_readfirstlane(tid >> 6);
    const int G = gridDim.x, bx = blockIdx.x;
#define PHASE_LOCAL() do { asm volatile("" : "+v"(tid)); lane = tid & 63; asm volatile("" : "+v"(lane)); } while (0)
    unsigned char* ws = a.ws; int seam_no = 0;
    bf16_t* XB = (bf16_t*)(ws + WS_XB); bf16_t* WinT = (bf16_t*)(ws + WS_WIN); bf16_t* WpT = (bf16_t*)(ws + WS_WP); bf16_t* WoutT = (bf16_t*)(ws + WS_WOUT);
    f32x2* csB = (f32x2*)(ws + WS_CSB); f32x2* csA = (f32x2*)(ws + WS_CSA); float* LSE = (float*)(ws + WS_LSE); f32x2* STATS = (f32x2*)(ws + WS_STATS);
    bf16_t* H = (bf16_t*)(ws + WS_H); bf16_t* MG = (bf16_t*)(ws + WS_XB);
    unsigned char* U8 = (unsigned char*)a.out + 32 * MiB;
    bf16_t* OG = (bf16_t*)((unsigned char*)a.out + 56 * MiB);
    unsigned char* U8_unused = (unsigned char*)a.out;
    unsigned char* MG8 = (unsigned char*)(ws + WS_XB);
    unsigned char* Wp8 = (unsigned char*)(ws + WS_WP); unsigned char* Wout8 = (unsigned char*)(ws + WS_WOUT);
    _Float16* Z16 = (_Float16*)(ws + WS_H);
    unsigned char* XB8 = (unsigned char*)a.out;

    if (bx == 0 && tid < 72) __hip_atomic_store((unsigned*)(ws + WS_CTL) + 1024 * (tid / 9) + 64 * (tid % 9), 0u, __ATOMIC_RELAXED, __HIP_MEMORY_SCOPE_AGENT);
    {
        const size_t gt = (size_t)bx * 512 + tid, GT = (size_t)G * 512;
        {
            const size_t NCH = (size_t)M * D / 8;
            for (size_t i0 = gt; i0 < NCH; i0 += 4 * GT) {
                f32x4 v[4][2];
#pragma unroll
                for (int u = 0; u < 4; ++u) { const size_t i = i0 + (size_t)u * GT; if (i < NCH) { v[u][0] = ((const f32x4*)a.x)[2 * i]; v[u][1] = ((const f32x4*)a.x)[2 * i + 1]; } }
#pragma unroll
                for (int u = 0; u < 4; ++u) { const size_t i = i0 + (size_t)u * GT; if (i < NCH) {
                    u32x4 w; w.x = cvt_pk_bf16(v[u][0][0], v[u][0][1]); w.y = cvt_pk_bf16(v[u][0][2], v[u][0][3]); w.z = cvt_pk_bf16(v[u][1][0], v[u][1][1]); w.w = cvt_pk_bf16(v[u][1][2], v[u][1][3]);
                    if (a.n_bf16 > 0) ((u32x4*)XB)[i] = w;
                    const unsigned p0 = pack_fp8x4(v[u][0][0], v[u][0][1], v[u][0][2], v[u][0][3]), p1 = pack_fp8x4(v[u][1][0], v[u][1][1], v[u][1][2], v[u][1][3]);
                    ((u32x2*)XB8)[i] = (u32x2){p0, p1}; } }
            }
        }
        for (size_t i = gt; i < (size_t)M * 64; i += GT) {
            const int t = (int)(i >> 6), j = (int)(i & 63);
            const float ang = (float)a.pos[t] * a.inv_freq[j];
            const double rev = (double)ang * 0.15915494309189535; const float fr = (float)(rev - __builtin_rint(rev));
            const f32x2 cs = (f32x2){__builtin_amdgcn_cosf(fr), __builtin_amdgcn_sinf(fr)};
            csB[i] = cs; if ((j & 1) == 0) csA[(size_t)t * 32 + (j >> 1)] = cs;
        }
        LAS float* scr = (LAS float*)(lds + wave * 16384);
        const int gw = bx * 8 + wave, NGW = G * 8;
        constexpr int I_IN = (D / 64) * (DIN / 32);
        for (int it = gw; it < I_IN; it += NGW) { const int nb = it % (DIN / 32), kb = it / (DIN / 32);
            if ((a.fp8mask >> (nb >> 3)) & 1ull) transpose_item_fp8(a.w_in, DIN, (unsigned char*)WinT, 4096, 0, 64 * kb, gemm_col_to_orig(32 * nb), 32 * nb, W8_SCALE, scr, lane);
            else transpose_item(a.w_in, DIN, WinT, D, 64 * kb, gemm_col_to_orig(32 * nb), 32 * nb, 0, scr, lane); }
    }
    GRID_SYNC();

    {
        if (a.n_fp8 > 0) {
            pg8::Gemm g{(const bf16_t*)XB8, WinT, D / 2, D}; pg8::OrderList S{M / 256, a.n_fp8, (M / 256) * a.n_fp8, G, bx, D / 128, a.tl_fp8};
            Epi1 E{H, csA, csB, a.b_gate, 0, 1.0f / W8_SCALE};
            pg8::gemm_phase<Epi1, pg8::OrderList, true>(lds, g, S, E);
        }
        {
            const int nwg = (M / 256) * (a.n_fp8 > 0 ? a.n_fp8 : a.n_bf16), rem = nwg % G; const int first = rem ? rem : 0, nhelp = G - first;
            if (bx >= first) {
                LAS float* scr = (LAS float*)(lds + wave * 16384);
                const int gw = (bx - first) * 8 + wave, NGW = nhelp * 8;
                constexpr int I_PA = (1024 / 64) * (D / 32), I_PB = (512 / 64) * (D / 32), I_OUT = (D / 64) * (D / 32);
                for (int it = gw; it < I_PA + I_PB + I_OUT; it += NGW) {
                    int r = it;
                    if (r < I_PA) { const int nb = r % (D / 32), kb = r / (D / 32); transpose_item_fp8(a.w_pa, D, Wp8, 1536, 0, 64 * kb, 32 * nb, 32 * nb, W8_SCALE, scr, lane); continue; } r -= I_PA;
                    if (r < I_PB) { const int nb = r % (D / 32), kb = r / (D / 32); transpose_item_fp8(a.w_pb, D, Wp8, 1536, 1024, 64 * kb, 32 * nb, 32 * nb, W8_SCALE, scr, lane); continue; } r -= I_PB;
                    { const int nb = r % (D / 32), kb = r / (D / 32); transpose_item_fp8(a.w_out, D, Wout8, 2048, 0, 64 * kb, 32 * nb, 32 * nb, W8_SCALE, scr, lane); }
                }
            }
        }
    }
    GRID_SYNC();

    {
        constexpr int N_A = 256, N_B = 1536;
        const bool xmap = (G % 8 == 0) && (N_A % 8 == 0) && (N_B % 8 == 0);
        const int xcd = bx & 7, jx = bx >> 3, perx = G >> 3;
        for (int i0 = bx; i0 < N_A + N_B; i0 += G) {
            int it = i0;
            if (xmap) { const int k = i0 / G;
                if (i0 < N_A) it = xcd * (N_A / 8) + k * perx + jx;
                else { const int kb = (i0 - N_A) / G; it = N_A + xcd * (N_B / 8) + kb * perx + jx; } }
            __syncthreads();
            if (it < N_A) {
                const int kvh = it & 1, b = it >> 1;
                LAS unsigned char* Kl = lds; LAS unsigned char* Vl = lds + 256 * 160;
                const int jlo = (b == 0) ? 128 : 0;
                load_kv<64>(Kl, Vl, H + OFF_KA + kvh * 64, H + OFF_VA + kvh * 64, (long)(b - 1) * 128, 1, jlo, tid);
                __syncthreads();
                const int head = kvh * 8 + wave; const float sink2 = a.sinks[head] * LOG2E;
                const int g4 = lane >> 4;
                bf16x8 qn[2]; u32x2 gn[4];
                { const size_t tok = (size_t)b * 128 + (lane & 15); const bf16_t* qr = H + tok * DIN + OFF_QA + head * 64; const bf16_t* gr = (const bf16_t*)((const unsigned char*)(H + tok * DIN + OFF_GA) + head * 64);
#pragma unroll
                  for (int ks = 0; ks < 2; ++ks) qn[ks] = *(const bf16x8*)(qr + ks * 32 + 8 * g4);
#pragma unroll
                  for (int dt = 0; dt < 4; ++dt) gn[dt] = (u32x2){*(const unsigned*)((const unsigned char*)gr + 16 * dt + 4 * g4), 0u}; }
                for (int c = 0; c < 8; ++c) {
                    const size_t tok = (size_t)b * 128 + c * 16 + (lane & 15);
                    const bf16x8 qc[2] = {qn[0], qn[1]}; const u32x2 gc[4] = {gn[0], gn[1], gn[2], gn[3]};
                    if (c < 7) { const size_t tn = tok + 16; const bf16_t* qr = H + tn * DIN + OFF_QA + head * 64; const bf16_t* gr = (const bf16_t*)((const unsigned char*)(H + tn * DIN + OFF_GA) + head * 64);
#pragma unroll
                        for (int ks = 0; ks < 2; ++ks) qn[ks] = *(const bf16x8*)(qr + ks * 32 + 8 * g4);
#pragma unroll
                        for (int dt = 0; dt < 4; ++dt) gn[dt] = (u32x2){*(const unsigned*)((const unsigned char*)gr + 16 * dt + 4 * g4), 0u}; }
                    attn_task<64, true>(Kl, Vl, qc, gc, nullptr, c * 16, jlo, sink2, nullptr, lane, U8 + tok * 1536 + head * 64);
                }
            } else {
                const int bi = it - N_A, grp = bi >> 9, rem = bi & 511, hs = rem >> 7, rb = rem & 127;
                const int dsh = 2 * grp, d = 1 << dsh;
                const int nblk = 128 >> dsh, r = rb / nblk, b = rb % nblk;
                LAS unsigned char* Kl = lds; LAS unsigned char* Vl = lds + 256 * 288;
                const int jlo = (b == 0) ? 128 : 0;
                const int colh = grp * 512 + hs * 128;
                load_kv<128>(Kl, Vl, H + OFF_KB + colh, H + OFF_VB + colh, ((long)(b - 1) * 128) * d + r, d, jlo, tid);
                __syncthreads();
                const size_t tok = ((size_t)b * 128 + wave * 16 + (lane & 15)) * d + r;
                const bf16_t* qrow = H + tok * DIN + OFF_QB + colh;
                bf16x8 qb4[4]; u32x2 gdum[8];
#pragma unroll
                for (int ks = 0; ks < 4; ++ks) qb4[ks] = *(const bf16x8*)(qrow + ks * 32 + 8 * (lane >> 4));
#pragma unroll
                for (int dt = 0; dt < 8; ++dt) gdum[dt] = (u32x2){0u, 0u};
                attn_task<128, false>(Kl, Vl, qb4, gdum, (bf16_t*)((unsigned char*)OG + ((size_t)grp * M + tok) * 512 + hs * 128), wave * 16, jlo, 0.f, LSE + ((size_t)grp * M + tok) * 4 + hs, lane, nullptr);
            }
        }
    }
    GRID_SYNC();

    {
        const int gw = bx * 8 + wave, NGW = G * 8;
        const int hs = lane >> 4, dc = (lane & 15) * 8;
        for (int t0 = gw; t0 < M; t0 += 2 * NGW) {
            float lw[2][3]; u32x2 ov[2][3], gv[2]; int tt[2];
#pragma unroll
            for (int u = 0; u < 2; ++u) { const int t = (t0 + u * NGW < M) ? t0 + u * NGW : t0; tt[u] = t;
                const bf16_t* hp = H + (size_t)t * DIN;
#pragma unroll
                for (int g3 = 0; g3 < 3; ++g3) { lw[u][g3] = LSE[((size_t)g3 * M + t) * 4 + hs]; ov[u][g3] = *(const u32x2*)((const unsigned char*)OG + ((size_t)g3 * M + t) * 512 + hs * 128 + dc); }
                gv[u] = *(const u32x2*)((const unsigned char*)(hp + OFF_GB) + hs * 128 + dc); }
#pragma unroll
            for (int u = 0; u < 2; ++u) {
                const float mxl = fmaxf(lw[u][0], fmaxf(lw[u][1], lw[u][2]));
                float w0 = fast_exp2(lw[u][0] - mxl), w1 = fast_exp2(lw[u][1] - mxl), w2 = fast_exp2(lw[u][2] - mxl);
                const float iw = fast_rcp(w0 + w1 + w2); w0 *= iw; w1 *= iw; w2 *= iw;
                f32x4 a0, a1, b0, b1, c0, c1, g0, g1;
                unpack_fp8x8(ov[u][0], a0, a1); unpack_fp8x8(ov[u][1], b0, b1); unpack_fp8x8(ov[u][2], c0, c1); unpack_fp8x8(gv[u], g0, g1);
                const f32x4 r0 = (a0 * w0 + b0 * w1 + c0 * w2) * g0, r1 = (a1 * w0 + b1 * w1 + c1 * w2) * g1;
                const unsigned p0 = pack_fp8x4(r0[0], r0[1], r0[2], r0[3]), p1 = pack_fp8x4(r1[0], r1[1], r1[2], r1[3]);
                if (u == 0 || tt[1] != tt[0]) *(u32x2*)(U8 + (size_t)tt[u] * 1536 + 1024 + hs * 128 + dc) = (u32x2){p0, p1};
            }
        }
    }
    GRID_SYNC();

    {
        pg8::Gemm g{(const bf16_t*)U8, (const bf16_t*)Wp8, 768, 768}; pg8::OrderTwoPart S{M / 256, D / 256, (M / 256) * (D / 256), G, bx, 512, 8, 4};
        Epi2 E{H, MG8, SM8 / (SU8 * W8_SCALE)};
        pg8::gemm_phase<Epi2, pg8::OrderTwoPart, true>(lds, g, S, E);
    }
    GRID_SYNC();

    {
        pg8::Gemm g{(const bf16_t*)MG8, (const bf16_t*)Wout8, D / 2, D / 2}; pg8::OrderPlain S{M / 256, D / 256, (M / 256) * (D / 256), G, bx, D / 128};
        Epi3 E{a.x, Z16, STATS, 1.0f / (SM8 * W8_SCALE)};
        pg8::gemm_phase<Epi3, pg8::OrderPlain, true>(lds, g, S, E);
    }
    GRID_SYNC();

    {
        const int xcd = bx & 7, cu_in_x = bx >> 3, per_x = G >> 3;
        const int gw = (G % 8 == 0) ? (cu_in_x * 8 + wave) : (bx * 8 + wave), NGW = (G % 8 == 0) ? per_x * 8 : G * 8;
        const int row_base = (G % 8 == 0) ? xcd * (M / 8) : 0, row_cnt = (G % 8 == 0) ? (M / 8) : M;
        typedef _Float16 h8 __attribute__((ext_vector_type(8)));
        f32x4 gg[8], bb[8];
#pragma unroll
        for (int j = 0; j < 4; ++j) { gg[2 * j] = *(const f32x4*)(a.ln_g + 512 * j + 8 * lane); gg[2 * j + 1] = *(const f32x4*)(a.ln_g + 512 * j + 8 * lane + 4);
                                      bb[2 * j] = *(const f32x4*)(a.ln_b + 512 * j + 8 * lane); bb[2 * j + 1] = *(const f32x4*)(a.ln_b + 512 * j + 8 * lane + 4); }
        for (int tl = gw; tl < row_cnt; tl += 2 * NGW) {
            const int t = row_base + tl; const int t1 = (tl + NGW < row_cnt) ? t + NGW : t;
            const f32x2 p0 = (lane < 32) ? STATS[(size_t)t * 32 + lane] : (f32x2){0.f, 0.f};
            const f32x2 p1 = (lane < 32) ? STATS[(size_t)t1 * 32 + lane] : (f32x2){0.f, 0.f};
            h8 z0[4], z1[4];
#pragma unroll
            for (int j = 0; j < 4; ++j) { z0[j] = *(const h8*)(Z16 + (size_t)t * D + 512 * j + 8 * lane); z1[j] = *(const h8*)(Z16 + (size_t)t1 * D + 512 * j + 8 * lane); }
            float s0 = p0.x, q0 = p0.y, s1 = p1.x, q1 = p1.y;
#pragma unroll
            for (int o = 1; o < 64; o <<= 1) { s0 += __shfl_xor(s0, o); q0 += __shfl_xor(q0, o); s1 += __shfl_xor(s1, o); q1 += __shfl_xor(q1, o); }
            const float m0 = s0 * (1.0f / D), m1 = s1 * (1.0f / D);
            const float r0 = 1.0f / sqrtf(fmaxf(q0 * (1.0f / D) - m0 * m0, 0.f) + LN_EPS), r1 = 1.0f / sqrtf(fmaxf(q1 * (1.0f / D) - m1 * m1, 0.f) + LN_EPS);
            float* o0 = a.out + (size_t)t * D + 8 * lane; float* o1 = a.out + (size_t)t1 * D + 8 * lane;
#pragma unroll
            for (int j = 0; j < 4; ++j) {
                const f32x4 a0 = (f32x4){(float)z0[j][0], (float)z0[j][1], (float)z0[j][2], (float)z0[j][3]}, a1 = (f32x4){(float)z0[j][4], (float)z0[j][5], (float)z0[j][6], (float)z0[j][7]};
                *(f32x4*)(o0 + 512 * j) = (a0 - m0) * r0 * gg[2 * j] + bb[2 * j]; *(f32x4*)(o0 + 512 * j + 4) = (a1 - m0) * r0 * gg[2 * j + 1] + bb[2 * j + 1];
            }
            if (t1 != t) {
#pragma unroll
                for (int j = 0; j < 4; ++j) {
                    const f32x4 a0 = (f32x4){(float)z1[j][0], (float)z1[j][1], (float)z1[j][2], (float)z1[j][3]}, a1 = (f32x4){(float)z1[j][4], (float)z1[j][5], (float)z1[j][6], (float)z1[j][7]};
                    *(f32x4*)(o1 + 512 * j) = (a0 - m1) * r1 * gg[2 * j] + bb[2 * j]; *(f32x4*)(o1 + 512 * j + 4) = (a1 - m1) * r1 * gg[2 * j + 1] + bb[2 * j + 1];
                }
            }
        }
    }
}

extern "C" void kernel_launch(void* const* d_in, const int* in_sizes, int n_in, void* d_out, int out_size, void* d_ws, size_t ws_size, hipStream_t stream) {
    static int grid = 0;
    if (grid == 0) {
        if (n_in != 10 || in_sizes[0] != M * D || out_size != M * D || ws_size < WS_END) { fprintf(stderr, "kernel_launch: unexpected shapes (n_in %d, in0 %d, out %d, ws %zu); nothing launched\n", n_in, n_in > 0 ? in_sizes[0] : -1, out_size, ws_size); grid = -1; return; }
        int dev = 0, cus = 0, per_cu = 0;
        hipGetDevice(&dev); hipDeviceGetAttribute(&cus, hipDeviceAttributeMultiprocessorCount, dev);
        if (hipFuncSetAttribute((const void*)hybrid_fwd, hipFuncAttributeMaxDynamicSharedMemorySize, LDS_BYTES) != hipSuccess) { fprintf(stderr, "kernel_launch: hipFuncSetAttribute failed\n"); grid = -1; return; }
        if (hipOccupancyMaxActiveBlocksPerMultiprocessor(&per_cu, (const void*)hybrid_fwd, 512, LDS_BYTES) != hipSuccess || per_cu < 1) { fprintf(stderr, "kernel_launch: occupancy query says %d blocks per CU\n", per_cu); per_cu = 1; }
        (void)hipGetLastError();
        grid = cus * 1;
    }
    if (grid < 0) return;
    Args a{};
    a.x = (const float*)d_in[0]; a.pos = (const int*)d_in[1]; a.w_in = (const float*)d_in[2]; a.b_gate = (const float*)d_in[3]; a.sinks = (const float*)d_in[4];
    a.w_pa = (const float*)d_in[5]; a.w_pb = (const float*)d_in[6]; a.w_out = (const float*)d_in[7]; a.ln_g = (const float*)d_in[8]; a.ln_b = (const float*)d_in[9];
    a.out = (float*)d_out; a.ws = (unsigned char*)d_ws;
    {
        for (int pn = 0; pn < DIN / 256; ++pn) { const bool f8 = true;
            if (f8) { a.tl_fp8[a.n_fp8++] = (unsigned char)pn; a.fp8mask |= 1ull << pn; } else a.tl_bf16[a.n_bf16++] = (unsigned char)pn; }
    }
    for (int j = 0; j < 64; ++j) a.inv_freq[j] = (float)pow(10000.0, -(double)j / 64.0);
    void* args[] = {&a};
    hipError_t e = hipLaunchCooperativeKernel((const void*)hybrid_fwd, dim3(grid), dim3(512), args, LDS_BYTES, stream);
    if (e != hipSuccess) fprintf(stderr, "kernel_launch: cooperative launch failed: %s (grid %d)\n", hipGetErrorString(e), grid);
}
```

```cpp
#include <hip/hip_runtime.h>
#include <hip/hip_cooperative_groups.h>
#include <cstdio>
#include <cstdint>
#include <cmath>
namespace cg = cooperative_groups;

#define LAS __attribute__((address_space(3)))
typedef unsigned short bf16_t;
typedef short bf16x8 __attribute__((ext_vector_type(8)));
typedef short bf16x4 __attribute__((ext_vector_type(4)));
typedef float f32x4 __attribute__((ext_vector_type(4)));
typedef float f32x2 __attribute__((ext_vector_type(2)));
typedef unsigned u32x4 __attribute__((ext_vector_type(4)));
typedef unsigned u32x2 __attribute__((ext_vector_type(2)));

constexpr int M = 16384, D = 2048, DIN = 11520;
constexpr int OFF_QA = 0, OFF_KA = 1024, OFF_VA = 1152, OFF_GA = 1280, OFF_QB = 2304, OFF_KB = 3840, OFF_VB = 5376, OFF_GB = 6912, OFF_MGA = 7424, OFF_MGB = 9472;
constexpr int OFF_UB = 1024;
constexpr float LOG2E = 1.4426950408889634f;
constexpr float SC_QA = 0.125f * LOG2E;
constexpr float SC_QB = 0.08838834764831845f * LOG2E;
constexpr float DN_ALPHA = 1.189207115002721f;
constexpr float LN_EPS = 1e-5f;
constexpr float W8_SCALE = 64.0f;
constexpr float SU8 = 16.0f, SM8 = 32.0f;
constexpr size_t MiB = 1u << 20;
constexpr size_t WS_XB = 0;
constexpr size_t WS_WIN = 64 * MiB;
constexpr size_t WS_WP = 110 * MiB;
constexpr size_t WS_WOUT = 116 * MiB;
constexpr size_t WS_CSB = 124 * MiB;
constexpr size_t WS_CSA = 132 * MiB;
constexpr size_t WS_LSE = 136 * MiB;
constexpr size_t WS_STATS = 137 * MiB;
constexpr size_t WS_CTL = 142 * MiB;
constexpr size_t WS_H = 144 * MiB;
constexpr size_t WS_END = 504 * MiB;
constexpr int LDS_BYTES = 147456;

__device__ __forceinline__ unsigned cvt_pk_bf16(float lo, float hi) { unsigned r; asm volatile("v_cvt_pk_bf16_f32 %0, %1, %2" : "=v"(r) : "v"(lo), "v"(hi)); return r; }
__device__ __forceinline__ float bf_lo(unsigned w) { return __uint_as_float(w << 16); }
__device__ __forceinline__ float bf_hi(unsigned w) { return __uint_as_float(w & 0xffff0000u); }
__device__ __forceinline__ float fast_rcp(float x) { return __builtin_amdgcn_rcpf(x); }
__device__ __forceinline__ float fast_exp2(float x) { return __builtin_amdgcn_exp2f(x); }
__device__ __forceinline__ float sigmoidf_(float v) { return fast_rcp(1.0f + fast_exp2(-v * LOG2E)); }

__device__ __forceinline__ unsigned pack_fp8x4(float a, float b, float c, float d) {
    const unsigned lo = (unsigned)__builtin_amdgcn_cvt_pk_fp8_f32(a, b, 0, false), hi = (unsigned)__builtin_amdgcn_cvt_pk_fp8_f32(c, d, 0, false);
    return (lo & 0xffffu) | (hi << 16);
}

__device__ __forceinline__ void unpack_fp8x8(u32x2 w, f32x4& lo, f32x4& hi) {
    typedef float f2 __attribute__((ext_vector_type(2)));
    const f2 a = __builtin_amdgcn_cvt_pk_f32_fp8((int)w.x, false), b = __builtin_amdgcn_cvt_pk_f32_fp8((int)w.x, true), c = __builtin_amdgcn_cvt_pk_f32_fp8((int)w.y, false), d = __builtin_amdgcn_cvt_pk_f32_fp8((int)w.y, true);
    lo = (f32x4){a[0], a[1], b[0], b[1]}; hi = (f32x4){c[0], c[1], d[0], d[1]};
}

namespace pg8 {
constexpr int BM = 256, BK = 64, HALF = 128, HTB = HALF * BK * 2, STAGE_BYTES = 8 * HTB, NXCD = 8, WGM = 2;
__host__ __device__ __forceinline__ int lds_byte(int r, int c) { const int st = (r >> 4) * 2 + (c >> 5), rr = r & 15, cc = c & 31, ob = rr * 64 + cc * 2; return st * 1024 + (ob ^ (((ob >> 9) & 1) << 5)); }
__host__ __device__ __forceinline__ void stage_rc(int b, int& R, int& C) { const int st = b / 1024, sb = b % 1024, swz = sb ^ (((sb >> 9) & 1) << 5); R = (st >> 1) * 16 + swz / 64; C = (st & 1) * 32 + (swz % 64) / 2; }
__host__ __device__ __forceinline__ int perm32(int rho) { const int n = rho >> 4, i = rho & 15; return 8 * (i >> 2) + 4 * n + (i & 3); }

typedef int v8i_t __attribute__((ext_vector_type(8))); typedef int v4i_t __attribute__((ext_vector_type(4)));
__device__ __forceinline__ v8i_t join8(bf16x8 lo, bf16x8 hi) { const v4i_t a = __builtin_bit_cast(v4i_t, lo), b = __builtin_bit_cast(v4i_t, hi); return __builtin_shufflevector(a, b, 0, 1, 2, 3, 4, 5, 6, 7); }
struct Unit { int pm, pn, k0, nt, part; };
struct Gemm { const bf16_t* A; const bf16_t* Bt; int lda, ldb; };

__device__ __forceinline__ void tile_of(int L, int nM, int nN, int& pm, int& pn) {
    const int nwg = nM * nN; int wgid = L;
    { const int q = nwg / NXCD, r = nwg % NXCD, xcd = wgid % NXCD, off = wgid / NXCD; wgid = (xcd < r ? xcd * (q + 1) : r * (q + 1) + (xcd - r) * q) + off; }
    const int nig = WGM * nN, gid = wgid / nig, fm = gid * WGM, gsz = (nM - fm) < WGM ? (nM - fm) : WGM;
    pm = fm + ((wgid % nig) % gsz); pn = (wgid % nig) / gsz;
}
struct OrderPlain {
    int nM, nN, nwg, G, c, nt;
    __device__ __forceinline__ bool next(int i, Unit& u) const { const long L = (long)i * G + c; if (L >= nwg) return false; tile_of((int)L, nM, nN, u.pm, u.pn); u.k0 = 0; u.nt = nt; u.part = 0; return true; }
};
struct OrderList {
    int nM, nN, nwg, G, c, nt; const unsigned char* list;
    __device__ __forceinline__ bool next(int i, Unit& u) const { const long L = (long)i * G + c; if (L >= nwg) return false; int j; tile_of((int)L, nM, nN, u.pm, j); u.pn = list[j]; u.k0 = 0; u.nt = nt; u.part = 0; return true; }
};
struct OrderTwoPart {
    int nM, nN, nwg, G, c, k1, nt0, nt1;
    __device__ __forceinline__ bool next(int i, Unit& u) const { const long L = (long)(i >> 1) * G + c; if (L >= nwg) return false; tile_of((int)L, nM, nN, u.pm, u.pn);
        u.part = i & 1; u.k0 = u.part ? k1 : 0; u.nt = u.part ? nt1 : nt0; return true; }
};

template <class Epi, class Sched, bool FP8 = false>
__device__ __forceinline__ void gemm_phase(LAS unsigned char* lds, const Gemm g, const Sched& S, const Epi& E) {
    const int tid = threadIdx.x;
    const int wid = __builtin_amdgcn_readfirstlane(tid >> 6), lane = tid & 63, wr = wid >> 2, wc = wid & 3, fr = lane & 15, fq = lane >> 4;
    unsigned voffA[2], voffB[2];
#pragma unroll
    for (int i = 0; i < 2; ++i) { int R, C; stage_rc(tid * 16 + i * 8192, R, C); const int Rb = Epi::PERM ? ((R & ~31) + perm32(R & 31)) : R;
        voffA[i] = (unsigned)(R * g.lda + C) * 2u; voffB[i] = (unsigned)(Rb * g.ldb + C) * 2u; }
    const size_t kstep = (size_t)(BK * 2);
    const size_t hstepA = (size_t)HALF * g.lda * 2, hstepB = (size_t)HALF * g.ldb * 2;
    const size_t tstepA = 2 * hstepA, tstepB = 2 * hstepB;
    const unsigned ldsw = (unsigned)wid * 1024u;
    const int aoff = lds_byte(wr * 64 + fr, fq * 8), boff = lds_byte(wc * 32 + fr, fq * 8);
#define PG8_SA(b, h) (((b) * 2 + (h)) * HTB)
#define PG8_SB(b, h) ((4 + (b) * 2 + (h)) * HTB)
#define PG8_STAGE(bufoff, gbase, voff) do { _Pragma("unroll") for (int _i = 0; _i < 2; ++_i) \
        __builtin_amdgcn_global_load_lds((const unsigned*)((const char*)(gbase) + (voff)[_i]), (LAS unsigned*)(lds + (bufoff) + ldsw + _i * 8192), 16, 0, 0); } while (0)
#define PG8_LDA(dst, b, h) do { _Pragma("unroll") for (int m = 0; m < 4; ++m) { \
        if constexpr (FP8) dst##8[m] = join8(*(const LAS bf16x8*)(lds + PG8_SA(b, h) + aoff + m * 2048), *(const LAS bf16x8*)(lds + PG8_SA(b, h) + aoff + m * 2048 + 1024)); \
        else { _Pragma("unroll") for (int k = 0; k < 2; ++k) dst[m][k] = *(const LAS bf16x8*)(lds + PG8_SA(b, h) + aoff + m * 2048 + k * 1024); } } } while (0)
#define PG8_LDB(dst, b, h) do { _Pragma("unroll") for (int n = 0; n < 2; ++n) { \
        if constexpr (FP8) dst##8[n] = join8(*(const LAS bf16x8*)(lds + PG8_SB(b, h) + boff + n * 2048), *(const LAS bf16x8*)(lds + PG8_SB(b, h) + boff + n * 2048 + 1024)); \
        else { _Pragma("unroll") for (int k = 0; k < 2; ++k) dst[n][k] = *(const LAS bf16x8*)(lds + PG8_SB(b, h) + boff + n * 2048 + k * 1024); } } } while (0)
#define PG8_MMA(ai, bj, At, Bt) do { __builtin_amdgcn_s_setprio(1); \
        if constexpr (FP8) { _Pragma("unroll") for (int m = 0; m < 4; ++m) _Pragma("unroll") for (int n = 0; n < 2; ++n) \
            asm volatile("v_mfma_scale_f32_16x16x128_f8f6f4 %0, %1, %2, %0, %3, %3 op_sel_hi:[0,0,0]" : "+v"(acc[ai][bj][m][n]) : "v"(Bt##8[n]), "v"(At##8[m]), "v"(fp8_one)); } \
        else { _Pragma("unroll") for (int m = 0; m < 4; ++m) _Pragma("unroll") for (int n = 0; n < 2; ++n) _Pragma("unroll") for (int k = 0; k < 2; ++k) \
            acc[ai][bj][m][n] = __builtin_amdgcn_mfma_f32_16x16x32_bf16(Bt[n][k], At[m][k], acc[ai][bj][m][n], 0, 0, 0); } \
        __builtin_amdgcn_s_setprio(0); } while (0)
#define PG8_WAIT_V(n) asm volatile("s_waitcnt vmcnt(" #n ")" ::: "memory")
#define PG8_WAIT_L(n) asm volatile("s_waitcnt lgkmcnt(" #n ")" ::: "memory")
#define PG8_BAR __builtin_amdgcn_s_barrier()
#define PG8_SCHED __builtin_amdgcn_sched_barrier(0)
    Unit cur, nxt; int ui = 0;
    if (!S.next(0, cur)) return;
    f32x4 acc[2][2][4][2];
#pragma unroll
    for (int a = 0; a < 2; ++a)
#pragma unroll
        for (int b = 0; b < 2; ++b)
#pragma unroll
            for (int m = 0; m < 4; ++m)
#pragma unroll
                for (int n = 0; n < 2; ++n) acc[a][b][m][n] = (f32x4){0.f, 0.f, 0.f, 0.f};
    const int fp8_one = 0x7F7F7F7F;
    bf16x8 At[4][2], B0[2][2], B1[2][2]; v8i_t At8[4], B08[2], B18[2];
    const char* cA = (const char*)g.A + (size_t)cur.pm * tstepA + (size_t)cur.k0 * 2; const char* cB = (const char*)g.Bt + (size_t)cur.pn * tstepB + (size_t)cur.k0 * 2;
    PG8_STAGE(PG8_SB(0, 0), cB, voffB); PG8_STAGE(PG8_SB(0, 1), cB + hstepB, voffB); PG8_STAGE(PG8_SA(0, 0), cA, voffA); PG8_STAGE(PG8_SA(0, 1), cA + hstepA, voffA);
    if (wr == 1) PG8_BAR;
    PG8_WAIT_V(2); PG8_BAR;
    PG8_STAGE(PG8_SB(1, 0), cB + kstep, voffB); PG8_STAGE(PG8_SA(1, 0), cA + kstep, voffA); PG8_STAGE(PG8_SB(1, 1), cB + hstepB + kstep, voffB);
    PG8_WAIT_V(6); PG8_BAR;
    for (;;) {
        const bool has_next = S.next(ui + 1, nxt);
        const char* nA = has_next ? (const char*)g.A + (size_t)nxt.pm * tstepA + (size_t)nxt.k0 * 2 : cA; const char* nB = has_next ? (const char*)g.Bt + (size_t)nxt.pn * tstepB + (size_t)nxt.k0 * 2 : cB;
        const int nt = cur.nt;
        for (int t = 0; t < nt; t += 2) {
            const bool last = (t == nt - 2);
            const char* a1 = cA + (size_t)(t + 1) * kstep;
            const char* a2 = last ? nA : cA + (size_t)(t + 2) * kstep; const char* b2 = last ? nB : cB + (size_t)(t + 2) * kstep;
            const char* a3 = a2 + kstep; const char* b3 = b2 + kstep;
            PG8_LDB(B0, 0, 0); PG8_LDB(B1, 0, 1); PG8_SCHED; PG8_LDA(At, 0, 0); PG8_STAGE(PG8_SA(1, 1), a1 + hstepA, voffA);
            PG8_WAIT_V(8); PG8_WAIT_L(0); PG8_BAR; PG8_MMA(0, 0, At, B0); PG8_MMA(0, 1, At, B1); PG8_BAR; PG8_SCHED;
            PG8_LDA(At, 0, 1); PG8_STAGE(PG8_SB(0, 0), b2, voffB); PG8_STAGE(PG8_SB(0, 1), b2 + hstepB, voffB); PG8_STAGE(PG8_SA(0, 0), a2, voffA);
            PG8_WAIT_V(8); PG8_WAIT_L(0); PG8_BAR; PG8_MMA(1, 0, At, B0); PG8_MMA(1, 1, At, B1); PG8_BAR; PG8_SCHED;
            PG8_LDB(B0, 1, 0); PG8_LDB(B1, 1, 1); PG8_SCHED; PG8_LDA(At, 1, 0); PG8_STAGE(PG8_SA(0, 1), a2 + hstepA, voffA);
            PG8_WAIT_V(8); PG8_WAIT_L(0); PG8_BAR; PG8_MMA(0, 0, At, B0); PG8_MMA(0, 1, At, B1); PG8_BAR; PG8_SCHED;
            PG8_LDA(At, 1, 1); PG8_STAGE(PG8_SB(1, 0), b3, voffB); PG8_STAGE(PG8_SB(1, 1), b3 + hstepB, voffB); PG8_STAGE(PG8_SA(1, 0), a3, voffA);
            PG8_WAIT_V(8); PG8_WAIT_L(0); PG8_BAR; PG8_MMA(1, 0, At, B0); PG8_MMA(1, 1, At, B1); PG8_BAR; PG8_SCHED;
        }
        if (wr == 0) PG8_BAR;
        if constexpr (FP8) asm volatile("s_nop 15\n\ts_nop 15" ::: "memory");
        E(acc, cur, wr, wc, fr, fq);
        if (!has_next) break;
        if (!E.keep(cur)) {
#pragma unroll
            for (int a = 0; a < 2; ++a)
#pragma unroll
                for (int b = 0; b < 2; ++b)
#pragma unroll
                    for (int m = 0; m < 4; ++m)
#pragma unroll
                        for (int n = 0; n < 2; ++n) acc[a][b][m][n] = (f32x4){0.f, 0.f, 0.f, 0.f};
        }
        cur = nxt; cA = nA; cB = nB; ++ui;
        if (wr == 1) PG8_BAR;
    }
    PG8_WAIT_V(0);
    PG8_BAR;
#undef PG8_SA
#undef PG8_SB
#undef PG8_STAGE
#undef PG8_LDA
#undef PG8_LDB
#undef PG8_MMA
#undef PG8_WAIT_V
#undef PG8_WAIT_L
#undef PG8_BAR
#undef PG8_SCHED
}
}

__host__ __device__ __forceinline__ int tile_mode(int pn) { return (pn <= 4) ? 1 : (pn >= 9 && pn <= 20) ? 2 : 0; }
__host__ __device__ __forceinline__ int gemm_col_to_orig(int nprime) {
    const int pn = nprime >> 8, xp = nprime & 255, bj = xp >> 7, x = xp & 127, md = tile_mode(pn);
    if (md == 1) return 256 * pn + 64 * (x >> 5) + (x & 31) + 32 * bj;
    if (md == 2) return 256 * pn + 128 * (x >> 6) + (x & 63) + 64 * bj;
    return nprime;
}

struct Epi1 {
    static constexpr bool PERM = true;
    bf16_t* H; const f32x2* csA; const f32x2* csB; const float* bgate; int pn_off; float ascale;
    __device__ __forceinline__ bool keep(const pg8::Unit&) const { return false; }
    __device__ __forceinline__ void operator()(f32x4 (&acc)[2][2][4][2], const pg8::Unit& u, int wr, int wc, int fr, int fq) const {
        const int pn = u.pn + pn_off, md = tile_mode(pn);
        const int row0 = u.pm * 256 + wr * 64 + fr;
        int col0, cstep;
        if (md == 1) { col0 = 256 * pn + 64 * wc + 8 * fq; cstep = 32; }
        else if (md == 2) { col0 = 256 * pn + 128 * (wc >> 1) + 32 * (wc & 1) + 8 * fq; cstep = 64; }
        else { col0 = 256 * pn + 32 * wc + 8 * fq; cstep = 128; }
        const bool rope = (md == 2) || (md == 1 && (pn < 4 || wc < 2));
        if (rope) {
            const float sc = ((pn < 4) ? SC_QA : (pn >= 9 && pn < 15) ? SC_QB : 1.0f) * ascale;
#pragma unroll
            for (int ai = 0; ai < 2; ++ai)
#pragma unroll
                for (int m = 0; m < 4; ++m) {
                    const int row = row0 + ai * 128 + m * 16;
                    const f32x4* cp = (md == 1) ? (const f32x4*)(csA + (size_t)row * 32 + 8 * fq) : (const f32x4*)(csB + (size_t)row * 64 + 32 * (wc & 1) + 8 * fq);
                    const f32x4 t0 = cp[0], t1 = cp[1], t2 = cp[2], t3 = cp[3];
                    const f32x4 a0 = acc[ai][0][m][0], a1 = acc[ai][0][m][1], b0 = acc[ai][1][m][0], b1 = acc[ai][1][m][1];
                    u32x4 w0, w1;
                    w0.x = cvt_pk_bf16((a0[0] * t0[0] - b0[0] * t0[1]) * sc, (a0[1] * t0[2] - b0[1] * t0[3]) * sc);
                    w0.y = cvt_pk_bf16((a0[2] * t1[0] - b0[2] * t1[1]) * sc, (a0[3] * t1[2] - b0[3] * t1[3]) * sc);
                    w0.z = cvt_pk_bf16((a1[0] * t2[0] - b1[0] * t2[1]) * sc, (a1[1] * t2[2] - b1[1] * t2[3]) * sc);
                    w0.w = cvt_pk_bf16((a1[2] * t3[0] - b1[2] * t3[1]) * sc, (a1[3] * t3[2] - b1[3] * t3[3]) * sc);
                    w1.x = cvt_pk_bf16((b0[0] * t0[0] + a0[0] * t0[1]) * sc, (b0[1] * t0[2] + a0[1] * t0[3]) * sc);
                    w1.y = cvt_pk_bf16((b0[2] * t1[0] + a0[2] * t1[1]) * sc, (b0[3] * t1[2] + a0[3] * t1[3]) * sc);
                    w1.z = cvt_pk_bf16((b1[0] * t2[0] + a1[0] * t2[1]) * sc, (b1[1] * t2[2] + a1[1] * t2[3]) * sc);
                    w1.w = cvt_pk_bf16((b1[2] * t3[0] + a1[2] * t3[1]) * sc, (b1[3] * t3[2] + a1[3] * t3[3]) * sc);
                    bf16_t* rp = H + (size_t)row * DIN + col0;
                    *(u32x4*)(rp) = w0; *(u32x4*)(rp + cstep) = w1;
                    if (m == 3) asm volatile("" ::: "memory");
                }
        } else {
            const int act = (pn >= 29) ? 2 : ((pn >= 5 && pn <= 8) || pn == 27 || pn == 28) ? 1 : 0;
            f32x4 bv[2][2];
#pragma unroll
            for (int bj = 0; bj < 2; ++bj)
#pragma unroll
                for (int n = 0; n < 2; ++n) bv[bj][n] = (act == 2) ? *(const f32x4*)(bgate + (col0 + bj * cstep - OFF_MGA) + 4 * n) : (f32x4){0.f, 0.f, 0.f, 0.f};
#pragma unroll
            for (int ai = 0; ai < 2; ++ai)
#pragma unroll
                for (int m = 0; m < 4; ++m) {
                    bf16_t* rp = H + (size_t)(row0 + ai * 128 + m * 16) * DIN + col0;
#pragma unroll
                    for (int bj = 0; bj < 2; ++bj) {
                        f32x4 v0 = acc[ai][bj][m][0] * ascale + bv[bj][0], v1 = acc[ai][bj][m][1] * ascale + bv[bj][1];
                        if (act == 1) {
#pragma unroll
                            for (int j = 0; j < 4; ++j) { v0[j] = v0[j] * sigmoidf_(v0[j]); v1[j] = v1[j] * sigmoidf_(v1[j]); } }
                        else if (act == 2) {
#pragma unroll
                            for (int j = 0; j < 4; ++j) { v0[j] = sigmoidf_(v0[j]); v1[j] = sigmoidf_(v1[j]); } }
                        if (act != 0) {
                            const int offx = (pn >= 37) ? OFF_MGB : (pn >= 29) ? OFF_MGA : (pn >= 27) ? OFF_GB : OFF_GA;
                            unsigned char* gp = (unsigned char*)(H + (size_t)(row0 + ai * 128 + m * 16) * DIN + offx) + (col0 + bj * cstep - offx);
                            *(u32x2*)gp = (u32x2){pack_fp8x4(v0[0], v0[1], v0[2], v0[3]), pack_fp8x4(v1[0], v1[1], v1[2], v1[3])};
                        } else {
                        u32x4 w; w.x = cvt_pk_bf16(v0[0], v0[1]); w.y = cvt_pk_bf16(v0[2], v0[3]); w.z = cvt_pk_bf16(v1[0], v1[1]); w.w = cvt_pk_bf16(v1[2], v1[3]);
                        *(u32x4*)(rp + bj * cstep) = w; }
                    }
                }
        }
    }
};

struct Epi2 {
    static constexpr bool PERM = true;
    const bf16_t* H; unsigned char* MG8; float oscale;
    __device__ __forceinline__ bool keep(const pg8::Unit& u) const { return u.part == 0; }
    __device__ __forceinline__ void operator()(f32x4 (&acc)[2][2][4][2], const pg8::Unit& u, int wr, int wc, int fr, int fq) const {
        const int row0 = u.pm * 256 + wr * 64 + fr, col0 = u.pn * 256 + wc * 32 + 8 * fq;
        if (u.part == 0) {
#pragma unroll
            for (int ai = 0; ai < 2; ++ai)
#pragma unroll
                for (int m = 0; m < 4; ++m) {
                    const bf16_t* hrow = H + (size_t)(row0 + ai * 128 + m * 16) * DIN;
#pragma unroll
                    for (int bj = 0; bj < 2; ++bj) {
                        const u32x2 sa = *(const u32x2*)((const unsigned char*)(hrow + OFF_MGA) + col0 + bj * 128), sb = *(const u32x2*)((const unsigned char*)(hrow + OFF_MGB) + col0 + bj * 128);
                        f32x4 a0, a1, b0, b1; unpack_fp8x8(sa, a0, a1); unpack_fp8x8(sb, b0, b1);
                        f32x4 r0, r1;
#pragma unroll
                        for (int e = 0; e < 4; ++e) { r0[e] = a0[e] * fast_rcp(fmaxf(b0[e], 1e-30f)); r1[e] = a1[e] * fast_rcp(fmaxf(b1[e], 1e-30f)); }
                        acc[ai][bj][m][0] *= r0; acc[ai][bj][m][1] *= r1;
                    }
                    if (m == 3) asm volatile("" ::: "memory");
                }
        } else {
#pragma unroll
            for (int ai = 0; ai < 2; ++ai)
#pragma unroll
                for (int m = 0; m < 4; ++m) {
                    const size_t rr = (size_t)(row0 + ai * 128 + m * 16);
                    const bf16_t* hrow = H + rr * DIN; unsigned char* op = MG8 + rr * D + col0;
#pragma unroll
                    for (int bj = 0; bj < 2; ++bj) {
                        const u32x2 sbw = *(const u32x2*)((const unsigned char*)(hrow + OFF_MGB) + col0 + bj * 128);
                        f32x4 b0, b1; unpack_fp8x8(sbw, b0, b1);
                        const f32x4 v0 = acc[ai][bj][m][0] * oscale * b0, v1 = acc[ai][bj][m][1] * oscale * b1;
                        const unsigned p0 = pack_fp8x4(v0[0], v0[1], v0[2], v0[3]), p1 = pack_fp8x4(v1[0], v1[1], v1[2], v1[3]);
                        *(u32x2*)(op + bj * 128) = (u32x2){p0, p1};
                    }
                    if (m == 3) asm volatile("" ::: "memory");
                }
        }
    }
};

struct Epi3 {
    static constexpr bool PERM = true;
    const float* x; _Float16* z16; f32x2* stats; float ascale;
    __device__ __forceinline__ bool keep(const pg8::Unit&) const { return false; }
    __device__ __forceinline__ void operator()(f32x4 (&acc)[2][2][4][2], const pg8::Unit& u, int wr, int wc, int fr, int fq) const {
        typedef _Float16 h8 __attribute__((ext_vector_type(8)));
        const int row0 = u.pm * 256 + wr * 64 + fr, col0 = u.pn * 256 + wc * 32 + 8 * fq;
#pragma unroll
        for (int ai = 0; ai < 2; ++ai)
#pragma unroll
            for (int m = 0; m < 4; ++m) {
                const int row = row0 + ai * 128 + m * 16; const size_t off = (size_t)row * D + col0;
                float s = 0.f, q = 0.f;
#pragma unroll
                for (int bj = 0; bj < 2; ++bj) {
                    const f32x4 x0 = *(const f32x4*)(x + off + bj * 128), x1 = *(const f32x4*)(x + off + bj * 128 + 4);
                    const f32x4 z0 = x0 * DN_ALPHA + acc[ai][bj][m][0] * ascale, z1 = x1 * DN_ALPHA + acc[ai][bj][m][1] * ascale;
                    *(h8*)(z16 + off + bj * 128) = (h8){(_Float16)z0[0], (_Float16)z0[1], (_Float16)z0[2], (_Float16)z0[3], (_Float16)z1[0], (_Float16)z1[1], (_Float16)z1[2], (_Float16)z1[3]};
                    s += ((z0[0] + z0[1]) + (z0[2] + z0[3])) + ((z1[0] + z1[1]) + (z1[2] + z1[3]));
                    q += ((z0[0] * z0[0] + z0[1] * z0[1]) + (z0[2] * z0[2] + z0[3] * z0[3])) + ((z1[0] * z1[0] + z1[1] * z1[1]) + (z1[2] * z1[2] + z1[3] * z1[3]));
                }
                s += __shfl_xor(s, 16); s += __shfl_xor(s, 32); q += __shfl_xor(q, 16); q += __shfl_xor(q, 32);
                if (fq == 0) stats[(size_t)row * 32 + u.pn * 4 + wc] = (f32x2){s, q};
                asm volatile("" ::: "memory");
            }
    }
};

__device__ __forceinline__ void transpose_item(const float* W, int N, bf16_t* WT, int ldt, int k0, int n_src, int n_dst, int kofs, LAS float* scr, int lane) {
    const int r8 = lane >> 3, c4 = lane & 7;
    f32x4 v[8];
#pragma unroll
    for (int i = 0; i < 8; ++i) v[i] = *(const f32x4*)(W + (size_t)(k0 + r8 + 8 * i) * N + n_src + 4 * c4);
#pragma unroll
    for (int i = 0; i < 8; ++i) { LAS float* d = scr + (r8 + 8 * i) * 33 + 4 * c4; d[0] = v[i][0]; d[1] = v[i][1]; d[2] = v[i][2]; d[3] = v[i][3]; }
    asm volatile("s_waitcnt lgkmcnt(0)" ::: "memory");
    const int c = lane & 7;
#pragma unroll
    for (int j = 0; j < 4; ++j) { const int n = (lane >> 3) + 8 * j; const LAS float* s = scr + (8 * c) * 33 + n;
        u32x4 o; o.x = cvt_pk_bf16(s[0 * 33], s[1 * 33]); o.y = cvt_pk_bf16(s[2 * 33], s[3 * 33]); o.z = cvt_pk_bf16(s[4 * 33], s[5 * 33]); o.w = cvt_pk_bf16(s[6 * 33], s[7 * 33]);
        *(u32x4*)(WT + (size_t)(n_dst + n) * ldt + kofs + k0 + 8 * c) = o; }
    asm volatile("s_waitcnt lgkmcnt(0)" ::: "memory");
}

__device__ __forceinline__ void transpose_item_fp8(const float* W, int N, unsigned char* W8, int pitch, int kofs, int k0, int n_src, int n_dst, float scale, LAS float* scr, int lane) {
    const int r8 = lane >> 3, c4 = lane & 7;
    f32x4 v[8];
#pragma unroll
    for (int i = 0; i < 8; ++i) v[i] = *(const f32x4*)(W + (size_t)(k0 + r8 + 8 * i) * N + n_src + 4 * c4);
#pragma unroll
    for (int i = 0; i < 8; ++i) { LAS float* d = scr + (r8 + 8 * i) * 33 + 4 * c4; d[0] = v[i][0]; d[1] = v[i][1]; d[2] = v[i][2]; d[3] = v[i][3]; }
    asm volatile("s_waitcnt lgkmcnt(0)" ::: "memory");
    const int n = lane & 31, cp = lane >> 5;
#pragma unroll
    for (int q = 0; q < 2; ++q) { const int ck = (2 * cp + q) * 16; const LAS float* sp = scr + ck * 33 + n; u32x4 o;
#pragma unroll
        for (int w = 0; w < 4; ++w) o[w] = pack_fp8x4(sp[(4 * w) * 33] * scale, sp[(4 * w + 1) * 33] * scale, sp[(4 * w + 2) * 33] * scale, sp[(4 * w + 3) * 33] * scale);
        *(u32x4*)(W8 + (size_t)(n_dst + n) * pitch + kofs + k0 + ck) = o; }
    asm volatile("s_waitcnt lgkmcnt(0)" ::: "memory");
}

template <int DH, bool IS_A>
__device__ __forceinline__ void attn_task(const LAS unsigned char* Kl, const LAS unsigned char* Vl, const bf16x8 (&qf)[DH / 32], const u32x2 (&gwv)[DH / 16], bf16_t* orow,
                                          int i0, int jlo, float sink2, float* lse_ptr, int lane, unsigned char* u8row) {
    constexpr int KS = (DH == 128) ? 288 : 160, VS = (DH == 128) ? 288 : 160, NKS = DH / 32, NDT = DH / 16;
    const int c16 = lane & 15, g = lane >> 4;
    f32x4 s[9];
    const LAS unsigned char* kp = Kl + (i0 + c16) * KS + 16 * g;
    bf16x8 kf[2][9];
#pragma unroll
    for (int T = 0; T < 9; ++T) { s[T] = (f32x4){0.f, 0.f, 0.f, 0.f}; kf[0][T] = *(const LAS bf16x8*)(kp + T * 16 * KS); }
#pragma unroll
    for (int ks = 0; ks < NKS; ++ks) {
        if (ks + 1 < NKS) {
#pragma unroll
            for (int T = 0; T < 9; ++T) kf[(ks + 1) & 1][T] = *(const LAS bf16x8*)(kp + T * 16 * KS + (ks + 1) * 64); }
        __builtin_amdgcn_sched_barrier(0);
#pragma unroll
        for (int T = 0; T < 9; ++T) s[T] = __builtin_amdgcn_mfma_f32_16x16x32_bf16(kf[ks & 1][T], qf[ks], s[T], 0, 0, 0);
        __builtin_amdgcn_sched_barrier(0);
    }
    const int i = i0 + c16; const int jmin = max(i + (IS_A ? 1 : 0), jlo), jmax = i + 128;
    float mx = -INFINITY;
#pragma unroll
    for (int T = 0; T < 9; ++T)
#pragma unroll
        for (int r = 0; r < 4; ++r) { const int j = i0 + 16 * T + 4 * g + r; const bool ok = (j >= jmin) && (j <= jmax); const float v = ok ? s[T][r] : -INFINITY; s[T][r] = v; mx = fmaxf(mx, v); }
    mx = fmaxf(mx, __shfl_xor(mx, 16)); mx = fmaxf(mx, __shfl_xor(mx, 32));
    if (IS_A) mx = fmaxf(mx, sink2);
    float sum = 0.f;
#pragma unroll
    for (int T = 0; T < 9; ++T)
#pragma unroll
        for (int r = 0; r < 4; ++r) { const float p = fast_exp2(s[T][r] - mx); s[T][r] = p; sum += p; }
    sum += __shfl_xor(sum, 16); sum += __shfl_xor(sum, 32);
    if (IS_A) sum += fast_exp2(sink2 - mx);
    bf16x8 pf[4];
#pragma unroll
    for (int k = 0; k < 4; ++k) { u32x4 w; w.x = cvt_pk_bf16(s[2 * k][0], s[2 * k][1]); w.y = cvt_pk_bf16(s[2 * k][2], s[2 * k][3]); w.z = cvt_pk_bf16(s[2 * k + 1][0], s[2 * k + 1][1]); w.w = cvt_pk_bf16(s[2 * k + 1][2], s[2 * k + 1][3]);
        pf[k] = __builtin_bit_cast(bf16x8, w); }
    bf16x4 p8; { u32x2 w; w.x = cvt_pk_bf16(s[8][0], s[8][1]); w.y = cvt_pk_bf16(s[8][2], s[8][3]); p8 = __builtin_bit_cast(bf16x4, w); }
    const int q4 = c16 >> 2, p4 = c16 & 3;
    const LAS unsigned char* vp = Vl + (i0 + 4 * g + q4) * VS + 8 * p4;
    const float inv = fast_rcp(sum);
    bf16x4 vv[2][9];
#pragma unroll
    for (int r9 = 0; r9 < 9; ++r9) vv[0][r9] = __builtin_amdgcn_ds_read_tr16_b64_v4i16((LAS bf16x4*)(vp + (16 * r9) * VS));
#pragma unroll
    for (int dt = 0; dt < NDT; ++dt) {
        if (dt + 1 < NDT) {
#pragma unroll
            for (int r9 = 0; r9 < 9; ++r9) vv[(dt + 1) & 1][r9] = __builtin_amdgcn_ds_read_tr16_b64_v4i16((LAS bf16x4*)(vp + (16 * r9) * VS + (dt + 1) * 32)); }
        __builtin_amdgcn_sched_barrier(0);
        f32x4 o = (f32x4){0.f, 0.f, 0.f, 0.f};
#pragma unroll
        for (int k = 0; k < 4; ++k) {
            const bf16x4 lo = vv[dt & 1][2 * k], hi = vv[dt & 1][2 * k + 1];
            o = __builtin_amdgcn_mfma_f32_16x16x32_bf16((bf16x8){lo[0], lo[1], lo[2], lo[3], hi[0], hi[1], hi[2], hi[3]}, pf[k], o, 0, 0, 0);
        }
        { const bf16x4 l8 = vv[dt & 1][8];
          o = __builtin_amdgcn_mfma_f32_16x16x32_bf16((bf16x8){l8[0], l8[1], l8[2], l8[3], l8[0], l8[1], l8[2], l8[3]}, (bf16x8){p8[0], p8[1], p8[2], p8[3], 0, 0, 0, 0}, o, 0, 0, 0); }
        __builtin_amdgcn_sched_barrier(0);
        o = o * inv;
        if (IS_A) { typedef float f2 __attribute__((ext_vector_type(2))); const f2 ga = __builtin_amdgcn_cvt_pk_f32_fp8((int)gwv[dt].x, false), gb = __builtin_amdgcn_cvt_pk_f32_fp8((int)gwv[dt].x, true);
            o[0] *= ga[0] * SU8; o[1] *= ga[1] * SU8; o[2] *= gb[0] * SU8; o[3] *= gb[1] * SU8;
            *(unsigned*)(u8row + 16 * dt + 4 * g) = pack_fp8x4(o[0], o[1], o[2], o[3]); }
        else *(unsigned*)((unsigned char*)orow + 16 * dt + 4 * g) = pack_fp8x4(o[0] * SU8, o[1] * SU8, o[2] * SU8, o[3] * SU8);
    }
    if (!IS_A) { if (g == 0) *lse_ptr = mx + __builtin_amdgcn_logf(sum); }
}

template <int DH>
__device__ __forceinline__ void load_kv(LAS unsigned char* Kl, LAS unsigned char* Vl, const bf16_t* Hk, const bf16_t* Hv, long tok0, int tstride, int jlo, int tid) {
    constexpr int KS = (DH == 128) ? 288 : 160, VS = (DH == 128) ? 288 : 160, CPR = DH / 8, PER = 256 * CPR / 512;
    u32x4 kv[PER], vv[PER];
#pragma unroll
    for (int c = 0; c < PER; ++c) { const int idx = c * 512 + tid, row = idx / CPR, ch = idx % CPR;
        if (row >= jlo) { const size_t off = (size_t)(tok0 + (long)row * tstride) * DIN + ch * 8; kv[c] = *(const u32x4*)(Hk + off); vv[c] = *(const u32x4*)(Hv + off); }
        else { kv[c] = (u32x4){0u, 0u, 0u, 0u}; vv[c] = (u32x4){0u, 0u, 0u, 0u}; } }
#pragma unroll
    for (int c = 0; c < PER; ++c) { const int idx = c * 512 + tid, row = idx / CPR, ch = idx % CPR;
        *(LAS u32x4*)(Kl + row * KS + ch * 16) = kv[c]; *(LAS u32x4*)(Vl + row * VS + ch * 16) = vv[c]; }
}


__device__ __forceinline__ void own_barrier(unsigned* cnt, unsigned G) {
    asm volatile("s_waitcnt vmcnt(0) lgkmcnt(0)" ::: "memory");
    __syncthreads();
    if (threadIdx.x == 0) {
        __builtin_amdgcn_fence(__ATOMIC_RELEASE, "agent"); asm volatile("s_waitcnt vmcnt(0)" ::: "memory");
        unsigned target;
        if ((G & 7u) == 0u) { target = 8u;
            const unsigned old = __hip_atomic_fetch_add(cnt + 64 * (1 + (blockIdx.x & 7)), 1u, __ATOMIC_RELAXED, __HIP_MEMORY_SCOPE_AGENT);
            if (old + 1u == (G >> 3)) __hip_atomic_fetch_add(cnt, 1u, __ATOMIC_RELAXED, __HIP_MEMORY_SCOPE_AGENT); }
        else { target = G; __hip_atomic_fetch_add(cnt, 1u, __ATOMIC_RELAXED, __HIP_MEMORY_SCOPE_AGENT); }
        unsigned spins = 0;
        while (__hip_atomic_load(cnt, __ATOMIC_RELAXED, __HIP_MEMORY_SCOPE_AGENT) < target && ++spins < (1u << 22)) __builtin_amdgcn_s_sleep(1);
        __builtin_amdgcn_fence(__ATOMIC_ACQUIRE, "agent"); asm volatile("s_waitcnt vmcnt(0)" ::: "memory");
    }
    __syncthreads();
}
#define GRID_SYNC() do { if (seam_no == 0) { asm volatile("s_waitcnt vmcnt(0) lgkmcnt(0)" ::: "memory"); grid.sync(); } else own_barrier((unsigned*)(ws + WS_CTL) + 1024 * seam_no, (unsigned)G); ++seam_no; } while (0)
struct Args {
    const float* x; const int* pos; const float* w_in; const float* b_gate; const float* sinks; const float* w_pa; const float* w_pb; const float* w_out; const float* ln_g; const float* ln_b;
    float* out; unsigned char* ws;
    float inv_freq[64];
    unsigned char tl_bf16[48], tl_fp8[48];
    int n_bf16, n_fp8; unsigned long long fp8mask;
};

__global__ void __launch_bounds__(512, 2) hybrid_fwd(Args a) {
    extern __shared__ __attribute__((aligned(16))) unsigned char lds_raw[];
    LAS unsigned char* lds = (LAS unsigned char*)lds_raw;
    cg::grid_group grid = cg::this_grid();
    int tid = threadIdx.x, lane = tid & 63; const int wave = __builtin_amdgcn_readfirstlane(tid >> 6);
    const int G = gridDim.x, bx = blockIdx.x;
#define PHASE_LOCAL() do { asm volatile("" : "+v"(tid)); lane = tid & 63; asm volatile("" : "+v"(lane)); } while (0)
    unsigned char* ws = a.ws; int seam_no = 0;
    bf16_t* XB = (bf16_t*)(ws + WS_XB); bf16_t* WinT = (bf16_t*)(ws + WS_WIN); bf16_t* WpT = (bf16_t*)(ws + WS_WP); bf16_t* WoutT = (bf16_t*)(ws + WS_WOUT);
    f32x2* csB = (f32x2*)(ws + WS_CSB); f32x2* csA = (f32x2*)(ws + WS_CSA); float* LSE = (float*)(ws + WS_LSE); f32x2* STATS = (f32x2*)(ws + WS_STATS);
    bf16_t* H = (bf16_t*)(ws + WS_H); bf16_t* MG = (bf16_t*)(ws + WS_XB);
    unsigned char* U8 = (unsigned char*)a.out + 32 * MiB;
    bf16_t* OG = (bf16_t*)((unsigned char*)a.out + 56 * MiB);
    unsigned char* U8_unused = (unsigned char*)a.out;
    unsigned char* MG8 = (unsigned char*)(ws + WS_XB);
    unsigned char* Wp8 = (unsigned char*)(ws + WS_WP); unsigned char* Wout8 = (unsigned char*)(ws + WS_WOUT);
    _Float16* Z16 = (_Float16*)(ws + WS_H);
    unsigned char* XB8 = (unsigned char*)a.out;

    if (bx == 0 && tid < 72) __hip_atomic_store((unsigned*)(ws + WS_CTL) + 1024 * (tid / 9) + 64 * (tid % 9), 0u, __ATOMIC_RELAXED, __HIP_MEMORY_SCOPE_AGENT);
    {
        const size_t gt = (size_t)bx * 512 + tid, GT = (size_t)G * 512;
        {
            const size_t NCH = (size_t)M * D / 8;
            for (size_t i0 = gt; i0 < NCH; i0 += 4 * GT) {
                f32x4 v[4][2];
#pragma unroll
                for (int u = 0; u < 4; ++u) { const size_t i = i0 + (size_t)u * GT; if (i < NCH) { v[u][0] = ((const f32x4*)a.x)[2 * i]; v[u][1] = ((const f32x4*)a.x)[2 * i + 1]; } }
#pragma unroll
                for (int u = 0; u < 4; ++u) { const size_t i = i0 + (size_t)u * GT; if (i < NCH) {
                    u32x4 w; w.x = cvt_pk_bf16(v[u][0][0], v[u][0][1]); w.y = cvt_pk_bf16(v[u][0][2], v[u][0][3]); w.z = cvt_pk_bf16(v[u][1][0], v[u][1][1]); w.w = cvt_pk_bf16(v[u][1][2], v[u][1][3]);
                    if (a.n_bf16 > 0) ((u32x4*)XB)[i] = w;
                    const unsigned p0 = pack_fp8x4(v[u][0][0], v[u][0][1], v[u][0][2], v[u][0][3]), p1 = pack_fp8x4(v[u][1][0], v[u][1][1], v[u][1][2], v[u][1][3]);
                    ((u32x2*)XB8)[i] = (u32x2){p0, p1}; } }
            }
        }
        for (size_t i = gt; i < (size_t)M * 64; i += GT) {
            const int t = (int)(i >> 6), j = (int)(i & 63);
            const float ang = (float)a.pos[t] * a.inv_freq[j];
            const double rev = (double)ang * 0.15915494309189535; const float fr = (float)(rev - __builtin_rint(rev));
            const f32x2 cs = (f32x2){__builtin_amdgcn_cosf(fr), __builtin_amdgcn_sinf(fr)};
            csB[i] = cs; if ((j & 1) == 0) csA[(size_t)t * 32 + (j >> 1)] = cs;
        }
        LAS float* scr = (LAS float*)(lds + wave * 16384);
        const int gw = bx * 8 + wave, NGW = G * 8;
        constexpr int I_IN = (D / 64) * (DIN / 32);
        for (int it = gw; it < I_IN; it += NGW) { const int nb = it % (DIN / 32), kb = it / (DIN / 32);
            if ((a.fp8mask >> (nb >> 3)) & 1ull) transpose_item_fp8(a.w_in, DIN, (unsigned char*)WinT, 4096, 0, 64 * kb, gemm_col_to_orig(32 * nb), 32 * nb, W8_SCALE, scr, lane);
            else transpose_item(a.w_in, DIN, WinT, D, 64 * kb, gemm_col_to_orig(32 * nb), 32 * nb, 0, scr, lane); }
    }
    GRID_SYNC();

    {
        if (a.n_fp8 > 0) {
            pg8::Gemm g{(const bf16_t*)XB8, WinT, D / 2, D}; pg8::OrderList S{M / 256, a.n_fp8, (M / 256) * a.n_fp8, G, bx, D / 128, a.tl_fp8};
            Epi1 E{H, csA, csB, a.b_gate, 0, 1.0f / W8_SCALE};
            pg8::gemm_phase<Epi1, pg8::OrderList, true>(lds, g, S, E);
        }
        {
            const int nwg = (M / 256) * (a.n_fp8 > 0 ? a.n_fp8 : a.n_bf16), rem = nwg % G; const int first = rem ? rem : 0, nhelp = G - first;
            if (bx >= first) {
                LAS float* scr = (LAS float*)(lds + wave * 16384);
                const int gw = (bx - first) * 8 + wave, NGW = nhelp * 8;
                constexpr int I_PA = (1024 / 64) * (D / 32), I_PB = (512 / 64) * (D / 32), I_OUT = (D / 64) * (D / 32);
                for (int it = gw; it < I_PA + I_PB + I_OUT; it += NGW) {
                    int r = it;
                    if (r < I_PA) { const int nb = r % (D / 32), kb = r / (D / 32); transpose_item_fp8(a.w_pa, D, Wp8, 1536, 0, 64 * kb, 32 * nb, 32 * nb, W8_SCALE, scr, lane); continue; } r -= I_PA;
                    if (r < I_PB) { const int nb = r % (D / 32), kb = r / (D / 32); transpose_item_fp8(a.w_pb, D, Wp8, 1536, 1024, 64 * kb, 32 * nb, 32 * nb, W8_SCALE, scr, lane); continue; } r -= I_PB;
                    { const int nb = r % (D / 32), kb = r / (D / 32); transpose_item_fp8(a.w_out, D, Wout8, 2048, 0, 64 * kb, 32 * nb, 32 * nb, W8_SCALE, scr, lane); }
                }
            }
        }
    }
    GRID_SYNC();

    {
        constexpr int N_A = 256, N_B = 1536;
        const bool xmap = (G % 8 == 0) && (N_A % 8 == 0) && (N_B % 8 == 0);
        const int xcd = bx & 7, jx = bx >> 3, perx = G >> 3;
        for (int i0 = bx; i0 < N_A + N_B; i0 += G) {
            int it = i0;
            if (xmap) { const int k = i0 / G;
                if (i0 < N_A) it = xcd * (N_A / 8) + k * perx + jx;
                else { const int kb = (i0 - N_A) / G; it = N_A + xcd * (N_B / 8) + kb * perx + jx; } }
            __syncthreads();
            if (it < N_A) {
                const int kvh = it & 1, b = it >> 1;
                LAS unsigned char* Kl = lds; LAS unsigned char* Vl = lds + 256 * 160;
                const int jlo = (b == 0) ? 128 : 0;
                load_kv<64>(Kl, Vl, H + OFF_KA + kvh * 64, H + OFF_VA + kvh * 64, (long)(b - 1) * 128, 1, jlo, tid);
                __syncthreads();
                const int head = kvh * 8 + wave; const float sink2 = a.sinks[head] * LOG2E;
                const int g4 = lane >> 4;
                bf16x8 qn[2]; u32x2 gn[4];
                { const size_t tok = (size_t)b * 128 + (lane & 15); const bf16_t* qr = H + tok * DIN + OFF_QA + head * 64; const bf16_t* gr = (const bf16_t*)((const unsigned char*)(H + tok * DIN + OFF_GA) + head * 64);
#pragma unroll
                  for (int ks = 0; ks < 2; ++ks) qn[ks] = *(const bf16x8*)(qr + ks * 32 + 8 * g4);
#pragma unroll
                  for (int dt = 0; dt < 4; ++dt) gn[dt] = (u32x2){*(const unsigned*)((const unsigned char*)gr + 16 * dt + 4 * g4), 0u}; }
                for (int c = 0; c < 8; ++c) {
                    const size_t tok = (size_t)b * 128 + c * 16 + (lane & 15);
                    const bf16x8 qc[2] = {qn[0], qn[1]}; const u32x2 gc[4] = {gn[0], gn[1], gn[2], gn[3]};
                    if (c < 7) { const size_t tn = tok + 16; const bf16_t* qr = H + tn * DIN + OFF_QA + head * 64; const bf16_t* gr = (const bf16_t*)((const unsigned char*)(H + tn * DIN + OFF_GA) + head * 64);
#pragma unroll
                        for (int ks = 0; ks < 2; ++ks) qn[ks] = *(const bf16x8*)(qr + ks * 32 + 8 * g4);
#pragma unroll
                        for (int dt = 0; dt < 4; ++dt) gn[dt] = (u32x2){*(const unsigned*)((const unsigned char*)gr + 16 * dt + 4 * g4), 0u}; }
                    attn_task<64, true>(Kl, Vl, qc, gc, nullptr, c * 16, jlo, sink2, nullptr, lane, U8 + tok * 1536 + head * 64);
                }
            } else {
                const int bi = it - N_A, grp = bi >> 9, rem = bi & 511, hs = rem >> 7, rb = rem & 127;
                const int dsh = 2 * grp, d = 1 << dsh;
                const int nblk = 128 >> dsh, r = rb / nblk, b = rb % nblk;
                LAS unsigned char* Kl = lds; LAS unsigned char* Vl = lds + 256 * 288;
                const int jlo = (b == 0) ? 128 : 0;
                const int colh = grp * 512 + hs * 128;
                load_kv<128>(Kl, Vl, H + OFF_KB + colh, H + OFF_VB + colh, ((long)(b - 1) * 128) * d + r, d, jlo, tid);
                __syncthreads();
                const size_t tok = ((size_t)b * 128 + wave * 16 + (lane & 15)) * d + r;
                const bf16_t* qrow = H + tok * DIN + OFF_QB + colh;
                bf16x8 qb4[4]; u32x2 gdum[8];
#pragma unroll
                for (int ks = 0; ks < 4; ++ks) qb4[ks] = *(const bf16x8*)(qrow + ks * 32 + 8 * (lane >> 4));
#pragma unroll
                for (int dt = 0; dt < 8; ++dt) gdum[dt] = (u32x2){0u, 0u};
                attn_task<128, false>(Kl, Vl, qb4, gdum, (bf16_t*)((unsigned char*)OG + ((size_t)grp * M + tok) * 512 + hs * 128), wave * 16, jlo, 0.f, LSE + ((size_t)grp * M + tok) * 4 + hs, lane, nullptr);
            }
        }
    }
    GRID_SYNC();

    {
        const int gw = bx * 8 + wave, NGW = G * 8;
        const int hs = lane >> 4, dc = (lane & 15) * 8;
        for (int t0 = gw; t0 < M; t0 += 2 * NGW) {
            float lw[2][3]; u32x2 ov[2][3], gv[2]; int tt[2];
#pragma unroll
            for (int u = 0; u < 2; ++u) { const int t = (t0 + u * NGW < M) ? t0 + u * NGW : t0; tt[u] = t;
                const bf16_t* hp = H + (size_t)t * DIN;
#pragma unroll
                for (int g3 = 0; g3 < 3; ++g3) { lw[u][g3] = LSE[((size_t)g3 * M + t) * 4 + hs]; ov[u][g3] = *(const u32x2*)((const unsigned char*)OG + ((size_t)g3 * M + t) * 512 + hs * 128 + dc); }
                gv[u] = *(const u32x2*)((const unsigned char*)(hp + OFF_GB) + hs * 128 + dc); }
#pragma unroll
            for (int u = 0; u < 2; ++u) {
                const float mxl = fmaxf(lw[u][0], fmaxf(lw[u][1], lw[u][2]));
                float w0 = fast_exp2(lw[u][0] - mxl), w1 = fast_exp2(lw[u][1] - mxl), w2 = fast_exp2(lw[u][2] - mxl);
                const float iw = fast_rcp(w0 + w1 + w2); w0 *= iw; w1 *= iw; w2 *= iw;
                f32x4 a0, a1, b0, b1, c0, c1, g0, g1;
                unpack_fp8x8(ov[u][0], a0, a1); unpack_fp8x8(ov[u][1], b0, b1); unpack_fp8x8(ov[u][2], c0, c1); unpack_fp8x8(gv[u], g0, g1);
                const f32x4 r0 = (a0 * w0 + b0 * w1 + c0 * w2) * g0, r1 = (a1 * w0 + b1 * w1 + c1 * w2) * g1;
                const unsigned p0 = pack_fp8x4(r0[0], r0[1], r0[2], r0[3]), p1 = pack_fp8x4(r1[0], r1[1], r1[2], r1[3]);
                if (u == 0 || tt[1] != tt[0]) *(u32x2*)(U8 + (size_t)tt[u] * 1536 + 1024 + hs * 128 + dc) = (u32x2){p0, p1};
            }
        }
    }
    GRID_SYNC();

    {
        pg8::Gemm g{(const bf16_t*)U8, (const bf16_t*)Wp8, 768, 768}; pg8::OrderTwoPart S{M / 256, D / 256, (M / 256) * (D / 256), G, bx, 512, 8, 4};
        Epi2 E{H, MG8, SM8 / (SU8 * W8_SCALE)};
        pg8::gemm_phase<Epi2, pg8::OrderTwoPart, true>(lds, g, S, E);
    }
    GRID_SYNC();

    {
        pg8::Gemm g{(const bf16_t*)MG8, (const bf16_t*)Wout8, D / 2, D / 2}; pg8::OrderPlain S{M / 256, D / 256, (M / 256) * (D / 256), G, bx, D / 128};
        Epi3 E{a.x, Z16, STATS, 1.0f / (SM8 * W8_SCALE)};
        pg8::gemm_phase<Epi3, pg8::OrderPlain, true>(lds, g, S, E);
    }
    GRID_SYNC();

    {
        const int xcd = bx & 7, cu_in_x = bx >> 3, per_x = G >> 3;
        const int gw = (G % 8 == 0) ? (cu_in_x * 8 + wave) : (bx * 8 + wave), NGW = (G % 8 == 0) ? per_x * 8 : G * 8;
        const int row_base = (G % 8 == 0) ? xcd * (M / 8) : 0, row_cnt = (G % 8 == 0) ? (M / 8) : M;
        typedef _Float16 h8 __attribute__((ext_vector_type(8)));
        f32x4 gg[8], bb[8];
#pragma unroll
        for (int j = 0; j < 4; ++j) { gg[2 * j] = *(const f32x4*)(a.ln_g + 512 * j + 8 * lane); gg[2 * j + 1] = *(const f32x4*)(a.ln_g + 512 * j + 8 * lane + 4);
                                      bb[2 * j] = *(const f32x4*)(a.ln_b + 512 * j + 8 * lane); bb[2 * j + 1] = *(const f32x4*)(a.ln_b + 512 * j + 8 * lane + 4); }
        for (int tl = gw; tl < row_cnt; tl += 2 * NGW) {
            const int t = row_base + tl; const int t1 = (tl + NGW < row_cnt) ? t + NGW : t;
            const f32x2 p0 = (lane < 32) ? STATS[(size_t)t * 32 + lane] : (f32x2){0.f, 0.f};
            const f32x2 p1 = (lane < 32) ? STATS[(size_t)t1 * 32 + lane] : (f32x2){0.f, 0.f};
            h8 z0[4], z1[4];
#pragma unroll
            for (int j = 0; j < 4; ++j) { z0[j] = *(const h8*)(Z16 + (size_t)t * D + 512 * j + 8 * lane); z1[j] = *(const h8*)(Z16 + (size_t)t1 * D + 512 * j + 8 * lane); }
            float s0 = p0.x, q0 = p0.y, s1 = p1.x, q1 = p1.y;
#pragma unroll
            for (int o = 1; o < 64; o <<= 1) { s0 += __shfl_xor(s0, o); q0 += __shfl_xor(q0, o); s1 += __shfl_xor(s1, o); q1 += __shfl_xor(q1, o); }
            const float m0 = s0 * (1.0f / D), m1 = s1 * (1.0f / D);
            const float r0 = 1.0f / sqrtf(fmaxf(q0 * (1.0f / D) - m0 * m0, 0.f) + LN_EPS), r1 = 1.0f / sqrtf(fmaxf(q1 * (1.0f / D) - m1 * m1, 0.f) + LN_EPS);
            float* o0 = a.out + (size_t)t * D + 8 * lane; float* o1 = a.out + (size_t)t1 * D + 8 * lane;
#pragma unroll
            for (int j = 0; j < 4; ++j) {
                const f32x4 a0 = (f32x4){(float)z0[j][0], (float)z0[j][1], (float)z0[j][2], (float)z0[j][3]}, a1 = (f32x4){(float)z0[j][4], (float)z0[j][5], (float)z0[j][6], (float)z0[j][7]};
                *(f32x4*)(o0 + 512 * j) = (a0 - m0) * r0 * gg[2 * j] + bb[2 * j]; *(f32x4*)(o0 + 512 * j + 4) = (a1 - m0) * r0 * gg[2 * j + 1] + bb[2 * j + 1];
            }
            if (t1 != t) {
#pragma unroll
                for (int j = 0; j < 4; ++j) {
                    const f32x4 a0 = (f32x4){(float)z1[j][0], (float)z1[j][1], (float)z1[j][2], (float)z1[j][3]}, a1 = (f32x4){(float)z1[j][4], (float)z1[j][5], (float)z1[j][6], (float)z1[j][7]};
                    *(f32x4*)(o1 + 512 * j) = (a0 - m1) * r1 * gg[2 * j] + bb[2 * j]; *(f32x4*)(o1 + 512 * j + 4) = (a1 - m1) * r1 * gg[2 * j + 1] + bb[2 * j + 1];
                }
            }
        }
    }
}

extern "C" void kernel_launch(void* const* d_in, const int* in_sizes, int n_in, void* d_out, int out_size, void* d_ws, size_t ws_size, hipStream_t stream) {
    static int grid = 0;
    if (grid == 0) {
        if (n_in != 10 || in_sizes[0] != M * D || out_size != M * D || ws_size < WS_END) { fprintf(stderr, "kernel_launch: unexpected shapes (n_in %d, in0 %d, out %d, ws %zu); nothing launched\n", n_in, n_in > 0 ? in_sizes[0] : -1, out_size, ws_size); grid = -1; return; }
        int dev = 0, cus = 0, per_cu = 0;
        hipGetDevice(&dev); hipDeviceGetAttribute(&cus, hipDeviceAttributeMultiprocessorCount, dev);
        if (hipFuncSetAttribute((const void*)hybrid_fwd, hipFuncAttributeMaxDynamicSharedMemorySize, LDS_BYTES) != hipSuccess) { fprintf(stderr, "kernel_launch: hipFuncSetAttribute failed\n"); grid = -1; return; }
        if (hipOccupancyMaxActiveBlocksPerMultiprocessor(&per_cu, (const void*)hybrid_fwd, 512, LDS_BYTES) != hipSuccess || per_cu < 1) { fprintf(stderr, "kernel_launch: occupancy query says %d blocks per CU\n", per_cu); per_cu = 1; }
        (void)hipGetLastError();
        grid = cus * 1;
    }
    if (grid < 0) return;
    Args a{};
    a.x = (const float*)d_in[0]; a.pos = (const int*)d_in[1]; a.w_in = (const float*)d_in[2]; a.b_gate = (const float*)d_in[3]; a.sinks = (const float*)d_in[4];
    a.w_pa = (const float*)d_in[5]; a.w_pb = (const float*)d_in[6]; a.w_out = (const float*)d_in[7]; a.ln_g = (const float*)d_in[8]; a.ln_b = (const float*)d_in[9];
    a.out = (float*)d_out; a.ws = (unsigned char*)d_ws;
    {
        for (int pn = 0; pn < DIN / 256; ++pn) { const bool f8 = true;
            if (f8) { a.tl_fp8[a.n_fp8++] = (unsigned char)pn; a.fp8mask |= 1ull << pn; } else a.tl_bf16[a.n_bf16++] = (unsigned char)pn; }
    }
    for (int j = 0; j < 64; ++j) a.inv_freq[j] = (float)pow(10000.0, -(double)j / 64.0);
    void* args[] = {&a};
    hipError_t e = hipLaunchCooperativeKernel((const void*)hybrid_fwd, dim3(grid), dim3(512), args, LDS_BYTES, stream);
    if (e != hipSuccess) fprintf(stderr, "kernel_launch: cooperative launch failed: %s (grid %d)\n", hipGetErrorString(e), grid);
}
```

```cpp
#include <hip/hip_runtime.h>
#include <hip/hip_cooperative_groups.h>
#include <cstdio>
#include <cstdint>
#include <cmath>
namespace cg = cooperative_groups;

#define LAS __attribute__((address_space(3)))
typedef unsigned short bf16_t;
typedef short bf16x8 __attribute__((ext_vector_type(8)));
typedef short bf16x4 __attribute__((ext_vector_type(4)));
typedef float f32x4 __attribute__((ext_vector_type(4)));
typedef float f32x2 __attribute__((ext_vector_type(2)));
typedef unsigned u32x4 __attribute__((ext_vector_type(4)));
typedef unsigned u32x2 __attribute__((ext_vector_type(2)));

constexpr int M = 16384, D = 2048, DIN = 11520;
constexpr int OFF_QA = 0, OFF_KA = 1024, OFF_VA = 1152, OFF_GA = 1280, OFF_QB = 2304, OFF_KB = 3840, OFF_VB = 5376, OFF_GB = 6912, OFF_MGA = 7424, OFF_MGB = 9472;
constexpr int OFF_UB = 1024;
constexpr float LOG2E = 1.4426950408889634f;
constexpr float SC_QA = 0.125f * LOG2E;
constexpr float SC_QB = 0.08838834764831845f * LOG2E;
constexpr float DN_ALPHA = 1.189207115002721f;
constexpr float LN_EPS = 1e-5f;
constexpr float W8_SCALE = 64.0f;
constexpr float SU8 = 16.0f, SM8 = 32.0f;
constexpr size_t MiB = 1u << 20;
constexpr size_t WS_XB = 0;
constexpr size_t WS_WIN = 64 * MiB;
constexpr size_t WS_WP = 110 * MiB;
constexpr size_t WS_WOUT = 116 * MiB;
constexpr size_t WS_CSB = 124 * MiB;
constexpr size_t WS_CSA = 132 * MiB;
constexpr size_t WS_LSE = 136 * MiB;
constexpr size_t WS_STATS = 137 * MiB;
constexpr size_t WS_CTL = 142 * MiB;
constexpr size_t WS_H = 144 * MiB;
constexpr size_t WS_END = 504 * MiB;
constexpr int LDS_BYTES = 147456;

__device__ __forceinline__ unsigned cvt_pk_bf16(float lo, float hi) { unsigned r; asm volatile("v_cvt_pk_bf16_f32 %0, %1, %2" : "=v"(r) : "v"(lo), "v"(hi)); return r; }
__device__ __forceinline__ float bf_lo(unsigned w) { return __uint_as_float(w << 16); }
__device__ __forceinline__ float bf_hi(unsigned w) { return __uint_as_float(w & 0xffff0000u); }
__device__ __forceinline__ float fast_rcp(float x) { return __builtin_amdgcn_rcpf(x); }
__device__ __forceinline__ float fast_exp2(float x) { return __builtin_amdgcn_exp2f(x); }
__device__ __forceinline__ float sigmoidf_(float v) { return fast_rcp(1.0f + fast_exp2(-v * LOG2E)); }

__device__ __forceinline__ unsigned pack_fp8x4(float a, float b, float c, float d) {
    const unsigned lo = (unsigned)__builtin_amdgcn_cvt_pk_fp8_f32(a, b, 0, false), hi = (unsigned)__builtin_amdgcn_cvt_pk_fp8_f32(c, d, 0, false);
    return (lo & 0xffffu) | (hi << 16);
}

__device__ __forceinline__ void unpack_fp8x8(u32x2 w, f32x4& lo, f32x4& hi) {
    typedef float f2 __attribute__((ext_vector_type(2)));
    const f2 a = __builtin_amdgcn_cvt_pk_f32_fp8((int)w.x, false), b = __builtin_amdgcn_cvt_pk_f32_fp8((int)w.x, true), c = __builtin_amdgcn_cvt_pk_f32_fp8((int)w.y, false), d = __builtin_amdgcn_cvt_pk_f32_fp8((int)w.y, true);
    lo = (f32x4){a[0], a[1], b[0], b[1]}; hi = (f32x4){c[0], c[1], d[0], d[1]};
}

namespace pg8 {
constexpr int BM = 256, BK = 64, HALF = 128, HTB = HALF * BK * 2, STAGE_BYTES = 8 * HTB, NXCD = 8, WGM = 2;
__host__ __device__ __forceinline__ int lds_byte(int r, int c) { const int st = (r >> 4) * 2 + (c >> 5), rr = r & 15, cc = c & 31, ob = rr * 64 + cc * 2; return st * 1024 + (ob ^ (((ob >> 9) & 1) << 5)); }
__host__ __device__ __forceinline__ void stage_rc(int b, int& R, int& C) { const int st = b / 1024, sb = b % 1024, swz = sb ^ (((sb >> 9) & 1) << 5); R = (st >> 1) * 16 + swz / 64; C = (st & 1) * 32 + (swz % 64) / 2; }
__host__ __device__ __forceinline__ int perm32(int rho) { const int n = rho >> 4, i = rho & 15; return 8 * (i >> 2) + 4 * n + (i & 3); }

typedef int v8i_t __attribute__((ext_vector_type(8))); typedef int v4i_t __attribute__((ext_vector_type(4)));
__device__ __forceinline__ v8i_t join8(bf16x8 lo, bf16x8 hi) { const v4i_t a = __builtin_bit_cast(v4i_t, lo), b = __builtin_bit_cast(v4i_t, hi); return __builtin_shufflevector(a, b, 0, 1, 2, 3, 4, 5, 6, 7); }
struct Unit { int pm, pn, k0, nt, part; };
struct Gemm { const bf16_t* A; const bf16_t* Bt; int lda, ldb; };

__device__ __forceinline__ void tile_of(int L, int nM, int nN, int& pm, int& pn) {
    const int nwg = nM * nN; int wgid = L;
    { const int q = nwg / NXCD, r = nwg % NXCD, xcd = wgid % NXCD, off = wgid / NXCD; wgid = (xcd < r ? xcd * (q + 1) : r * (q + 1) + (xcd - r) * q) + off; }
    const int nig = WGM * nN, gid = wgid / nig, fm = gid * WGM, gsz = (nM - fm) < WGM ? (nM - fm) : WGM;
    pm = fm + ((wgid % nig) % gsz); pn = (wgid % nig) / gsz;
}
struct OrderPlain {
    int nM, nN, nwg, G, c, nt;
    __device__ __forceinline__ bool next(int i, Unit& u) const { const long L = (long)i * G + c; if (L >= nwg) return false; tile_of((int)L, nM, nN, u.pm, u.pn); u.k0 = 0; u.nt = nt; u.part = 0; return true; }
};
struct OrderList {
    int nM, nN, nwg, G, c, nt; const unsigned char* list;
    __device__ __forceinline__ bool next(int i, Unit& u) const { const long L = (long)i * G + c; if (L >= nwg) return false; int j; tile_of((int)L, nM, nN, u.pm, j); u.pn = list[j]; u.k0 = 0; u.nt = nt; u.part = 0; return true; }
};
struct OrderTwoPart {
    int nM, nN, nwg, G, c, k1, nt0, nt1;
    __device__ __forceinline__ bool next(int i, Unit& u) const { const long L = (long)(i >> 1) * G + c; if (L >= nwg) return false; tile_of((int)L, nM, nN, u.pm, u.pn);
        u.part = i & 1; u.k0 = u.part ? k1 : 0; u.nt = u.part ? nt1 : nt0; return true; }
};

template <class Epi, class Sched, bool FP8 = false>
__device__ __forceinline__ void gemm_phase(LAS unsigned char* lds, const Gemm g, const Sched& S, const Epi& E) {
    const int tid = threadIdx.x;
    const int wid = __builtin_amdgcn_readfirstlane(tid >> 6), lane = tid & 63, wr = wid >> 2, wc = wid & 3, fr = lane & 15, fq = lane >> 4;
    unsigned voffA[2], voffB[2];
#pragma unroll
    for (int i = 0; i < 2; ++i) { int R, C; stage_rc(tid * 16 + i * 8192, R, C); const int Rb = Epi::PERM ? ((R & ~31) + perm32(R & 31)) : R;
        voffA[i] = (unsigned)(R * g.lda + C) * 2u; voffB[i] = (unsigned)(Rb * g.ldb + C) * 2u; }
    const size_t kstep = (size_t)(BK * 2);
    const size_t hstepA = (size_t)HALF * g.lda * 2, hstepB = (size_t)HALF * g.ldb * 2;
    const size_t tstepA = 2 * hstepA, tstepB = 2 * hstepB;
    const unsigned ldsw = (unsigned)wid * 1024u;
    const int aoff = lds_byte(wr * 64 + fr, fq * 8), boff = lds_byte(wc * 32 + fr, fq * 8);
#define PG8_SA(b, h) (((b) * 2 + (h)) * HTB)
#define PG8_SB(b, h) ((4 + (b) * 2 + (h)) * HTB)
#define PG8_STAGE(bufoff, gbase, voff) do { _Pragma("unroll") for (int _i = 0; _i < 2; ++_i) \
        __builtin_amdgcn_global_load_lds((const unsigned*)((const char*)(gbase) + (voff)[_i]), (LAS unsigned*)(lds + (bufoff) + ldsw + _i * 8192), 16, 0, 0); } while (0)
#define PG8_LDA(dst, b, h) do { _Pragma("unroll") for (int m = 0; m < 4; ++m) { \
        if constexpr (FP8) dst##8[m] = join8(*(const LAS bf16x8*)(lds + PG8_SA(b, h) + aoff + m * 2048), *(const LAS bf16x8*)(lds + PG8_SA(b, h) + aoff + m * 2048 + 1024)); \
        else { _Pragma("unroll") for (int k = 0; k < 2; ++k) dst[m][k] = *(const LAS bf16x8*)(lds + PG8_SA(b, h) + aoff + m * 2048 + k * 1024); } } } while (0)
#define PG8_LDB(dst, b, h) do { _Pragma("unroll") for (int n = 0; n < 2; ++n) { \
        if constexpr (FP8) dst##8[n] = join8(*(const LAS bf16x8*)(lds + PG8_SB(b, h) + boff + n * 2048), *(const LAS bf16x8*)(lds + PG8_SB(b, h) + boff + n * 2048 + 1024)); \
        else { _Pragma("unroll") for (int k = 0; k < 2; ++k) dst[n][k] = *(const LAS bf16x8*)(lds + PG8_SB(b, h) + boff + n * 2048 + k * 1024); } } } while (0)
#define PG8_MMA(ai, bj, At, Bt) do { __builtin_amdgcn_s_setprio(1); \
        if constexpr (FP8) { _Pragma("unroll") for (int m = 0; m < 4; ++m) _Pragma("unroll") for (int n = 0; n < 2; ++n) \
            asm volatile("v_mfma_scale_f32_16x16x128_f8f6f4 %0, %1, %2, %0, %3, %3 op_sel_hi:[0,0,0]" : "+v"(acc[ai][bj][m][n]) : "v"(Bt##8[n]), "v"(At##8[m]), "v"(fp8_one)); } \
        else { _Pragma("unroll") for (int m = 0; m < 4; ++m) _Pragma("unroll") for (int n = 0; n < 2; ++n) _Pragma("unroll") for (int k = 0; k < 2; ++k) \
            acc[ai][bj][m][n] = __builtin_amdgcn_mfma_f32_16x16x32_bf16(Bt[n][k], At[m][k], acc[ai][bj][m][n], 0, 0, 0); } \
        __builtin_amdgcn_s_setprio(0); } while (0)
#define PG8_WAIT_V(n) asm volatile("s_waitcnt vmcnt(" #n ")" ::: "memory")
#define PG8_WAIT_L(n) asm volatile("s_waitcnt lgkmcnt(" #n ")" ::: "memory")
#define PG8_BAR __builtin_amdgcn_s_barrier()
#define PG8_SCHED __builtin_amdgcn_sched_barrier(0)
    Unit cur, nxt; int ui = 0;
    if (!S.next(0, cur)) return;
    f32x4 acc[2][2][4][2];
#pragma unroll
    for (int a = 0; a < 2; ++a)
#pragma unroll
        for (int b = 0; b < 2; ++b)
#pragma unroll
            for (int m = 0; m < 4; ++m)
#pragma unroll
                for (int n = 0; n < 2; ++n) acc[a][b][m][n] = (f32x4){0.f, 0.f, 0.f, 0.f};
    const int fp8_one = 0x7F7F7F7F;
    bf16x8 At[4][2], B0[2][2], B1[2][2]; v8i_t At8[4], B08[2], B18[2];
    const char* cA = (const char*)g.A + (size_t)cur.pm * tstepA + (size_t)cur.k0 * 2; const char* cB = (const char*)g.Bt + (size_t)cur.pn * tstepB + (size_t)cur.k0 * 2;
    PG8_STAGE(PG8_SB(0, 0), cB, voffB); PG8_STAGE(PG8_SB(0, 1), cB + hstepB, voffB); PG8_STAGE(PG8_SA(0, 0), cA, voffA); PG8_STAGE(PG8_SA(0, 1), cA + hstepA, voffA);
    if (wr == 1) PG8_BAR;
    PG8_WAIT_V(2); PG8_BAR;
    PG8_STAGE(PG8_SB(1, 0), cB + kstep, voffB); PG8_STAGE(PG8_SA(1, 0), cA + kstep, voffA); PG8_STAGE(PG8_SB(1, 1), cB + hstepB + kstep, voffB);
    PG8_WAIT_V(6); PG8_BAR;
    for (;;) {
        const bool has_next = S.next(ui + 1, nxt);
        const char* nA = has_next ? (const char*)g.A + (size_t)nxt.pm * tstepA + (size_t)nxt.k0 * 2 : cA; const char* nB = has_next ? (const char*)g.Bt + (size_t)nxt.pn * tstepB + (size_t)nxt.k0 * 2 : cB;
        const int nt = cur.nt;
        for (int t = 0; t < nt; t += 2) {
            const bool last = (t == nt - 2);
            const char* a1 = cA + (size_t)(t + 1) * kstep;
            const char* a2 = last ? nA : cA + (size_t)(t + 2) * kstep; const char* b2 = last ? nB : cB + (size_t)(t + 2) * kstep;
            const char* a3 = a2 + kstep; const char* b3 = b2 + kstep;
            PG8_LDB(B0, 0, 0); PG8_LDB(B1, 0, 1); PG8_SCHED; PG8_LDA(At, 0, 0); PG8_STAGE(PG8_SA(1, 1), a1 + hstepA, voffA);
            PG8_WAIT_V(8); PG8_WAIT_L(0); PG8_BAR; PG8_MMA(0, 0, At, B0); PG8_MMA(0, 1, At, B1); PG8_BAR; PG8_SCHED;
            PG8_LDA(At, 0, 1); PG8_STAGE(PG8_SB(0, 0), b2, voffB); PG8_STAGE(PG8_SB(0, 1), b2 + hstepB, voffB); PG8_STAGE(PG8_SA(0, 0), a2, voffA);
            PG8_WAIT_V(8); PG8_WAIT_L(0); PG8_BAR; PG8_MMA(1, 0, At, B0); PG8_MMA(1, 1, At, B1); PG8_BAR; PG8_SCHED;
            PG8_LDB(B0, 1, 0); PG8_LDB(B1, 1, 1); PG8_SCHED; PG8_LDA(At, 1, 0); PG8_STAGE(PG8_SA(0, 1), a2 + hstepA, voffA);
            PG8_WAIT_V(8); PG8_WAIT_L(0); PG8_BAR; PG8_MMA(0, 0, At, B0); PG8_MMA(0, 1, At, B1); PG8_BAR; PG8_SCHED;
            PG8_LDA(At, 1, 1); PG8_STAGE(PG8_SB(1, 0), b3, voffB); PG8_STAGE(PG8_SB(1, 1), b3 + hstepB, voffB); PG8_STAGE(PG8_SA(1, 0), a3, voffA);
            PG8_WAIT_V(8); PG8_WAIT_L(0); PG8_BAR; PG8_MMA(1, 0, At, B0); PG8_MMA(1, 1, At, B1); PG8_BAR; PG8_SCHED;
        }
        if (wr == 0) PG8_BAR;
        if constexpr (FP8) asm volatile("s_nop 15\n\ts_nop 15" ::: "memory");
        E(acc, cur, wr, wc, fr, fq);
        if (!has_next) break;
        if (!E.keep(cur)) {
#pragma unroll
            for (int a = 0; a < 2; ++a)
#pragma unroll
                for (int b = 0; b < 2; ++b)
#pragma unroll
                    for (int m = 0; m < 4; ++m)
#pragma unroll
                        for (int n = 0; n < 2; ++n) acc[a][b][m][n] = (f32x4){0.f, 0.f, 0.f, 0.f};
        }
        cur = nxt; cA = nA; cB = nB; ++ui;
        if (wr == 1) PG8_BAR;
    }
    PG8_WAIT_V(0);
    PG8_BAR;
#undef PG8_SA
#undef PG8_SB
#undef PG8_STAGE
#undef PG8_LDA
#undef PG8_LDB
#undef PG8_MMA
#undef PG8_WAIT_V
#undef PG8_WAIT_L
#undef PG8_BAR
#undef PG8_SCHED
}
}

__host__ __device__ __forceinline__ int tile_mode(int pn) { return (pn <= 4) ? 1 : (pn >= 9 && pn <= 20) ? 2 : 0; }
__host__ __device__ __forceinline__ int gemm_col_to_orig(int nprime) {
    const int pn = nprime >> 8, xp = nprime & 255, bj = xp >> 7, x = xp & 127, md = tile_mode(pn);
    if (md == 1) return 256 * pn + 64 * (x >> 5) + (x & 31) + 32 * bj;
    if (md == 2) return 256 * pn + 128 * (x >> 6) + (x & 63) + 64 * bj;
    return nprime;
}

struct Epi1 {
    static constexpr bool PERM = true;
    bf16_t* H; const f32x2* csA; const f32x2* csB; const float* bgate; int pn_off; float ascale;
    __device__ __forceinline__ bool keep(const pg8::Unit&) const { return false; }
    __device__ __forceinline__ void operator()(f32x4 (&acc)[2][2][4][2], const pg8::Unit& u, int wr, int wc, int fr, int fq) const {
        const int pn = u.pn + pn_off, md = tile_mode(pn);
        const int row0 = u.pm * 256 + wr * 64 + fr;
        int col0, cstep;
        if (md == 1) { col0 = 256 * pn + 64 * wc + 8 * fq; cstep = 32; }
        else if (md == 2) { col0 = 256 * pn + 128 * (wc >> 1) + 32 * (wc & 1) + 8 * fq; cstep = 64; }
        else { col0 = 256 * pn + 32 * wc + 8 * fq; cstep = 128; }
        const bool rope = (md == 2) || (md == 1 && (pn < 4 || wc < 2));
        if (rope) {
            const float sc = ((pn < 4) ? SC_QA : (pn >= 9 && pn < 15) ? SC_QB : 1.0f) * ascale;
#pragma unroll
            for (int ai = 0; ai < 2; ++ai)
#pragma unroll
                for (int m = 0; m < 4; ++m) {
                    const int row = row0 + ai * 128 + m * 16;
                    const f32x4* cp = (md == 1) ? (const f32x4*)(csA + (size_t)row * 32 + 8 * fq) : (const f32x4*)(csB + (size_t)row * 64 + 32 * (wc & 1) + 8 * fq);
                    const f32x4 t0 = cp[0], t1 = cp[1], t2 = cp[2], t3 = cp[3];
                    const f32x4 a0 = acc[ai][0][m][0], a1 = acc[ai][0][m][1], b0 = acc[ai][1][m][0], b1 = acc[ai][1][m][1];
                    u32x4 w0, w1;
                    w0.x = cvt_pk_bf16((a0[0] * t0[0] - b0[0] * t0[1]) * sc, (a0[1] * t0[2] - b0[1] * t0[3]) * sc);
                    w0.y = cvt_pk_bf16((a0[2] * t1[0] - b0[2] * t1[1]) * sc, (a0[3] * t1[2] - b0[3] * t1[3]) * sc);
                    w0.z = cvt_pk_bf16((a1[0] * t2[0] - b1[0] * t2[1]) * sc, (a1[1] * t2[2] - b1[1] * t2[3]) * sc);
                    w0.w = cvt_pk_bf16((a1[2] * t3[0] - b1[2] * t3[1]) * sc, (a1[3] * t3[2] - b1[3] * t3[3]) * sc);
                    w1.x = cvt_pk_bf16((b0[0] * t0[0] + a0[0] * t0[1]) * sc, (b0[1] * t0[2] + a0[1] * t0[3]) * sc);
                    w1.y = cvt_pk_bf16((b0[2] * t1[0] + a0[2] * t1[1]) * sc, (b0[3] * t1[2] + a0[3] * t1[3]) * sc);
                    w1.z = cvt_pk_bf16((b1[0] * t2[0] + a1[0] * t2[1]) * sc, (b1[1] * t2[2] + a1[1] * t2[3]) * sc);
                    w1.w = cvt_pk_bf16((b1[2] * t3[0] + a1[2] * t3[1]) * sc, (b1[3] * t3[2] + a1[3] * t3[3]) * sc);
                    bf16_t* rp = H + (size_t)row * DIN + col0;
                    *(u32x4*)(rp) = w0; *(u32x4*)(rp + cstep) = w1;
                    if (m == 3) asm volatile("" ::: "memory");
                }
        } else {
            const int act = (pn >= 29) ? 2 : ((pn >= 5 && pn <= 8) || pn == 27 || pn == 28) ? 1 : 0;
            f32x4 bv[2][2];
#pragma unroll
            for (int bj = 0; bj < 2; ++bj)
#pragma unroll
                for (int n = 0; n < 2; ++n) bv[bj][n] = (act == 2) ? *(const f32x4*)(bgate + (col0 + bj * cstep - OFF_MGA) + 4 * n) : (f32x4){0.f, 0.f, 0.f, 0.f};
#pragma unroll
            for (int ai = 0; ai < 2; ++ai)
#pragma unroll
                for (int m = 0; m < 4; ++m) {
                    bf16_t* rp = H + (size_t)(row0 + ai * 128 + m * 16) * DIN + col0;
#pragma unroll
                    for (int bj = 0; bj < 2; ++bj) {
                        f32x4 v0 = acc[ai][bj][m][0] * ascale + bv[bj][0], v1 = acc[ai][bj][m][1] * ascale + bv[bj][1];
                        if (act == 1) {
#pragma unroll
                            for (int j = 0; j < 4; ++j) { v0[j] = v0[j] * sigmoidf_(v0[j]); v1[j] = v1[j] * sigmoidf_(v1[j]); } }
                        else if (act == 2) {
#pragma unroll
                            for (int j = 0; j < 4; ++j) { v0[j] = sigmoidf_(v0[j]); v1[j] = sigmoidf_(v1[j]); } }
                        if (act != 0) {
                            const int offx = (pn >= 37) ? OFF_MGB : (pn >= 29) ? OFF_MGA : (pn >= 27) ? OFF_GB : OFF_GA;
                            unsigned char* gp = (unsigned char*)(H + (size_t)(row0 + ai * 128 + m * 16) * DIN + offx) + (col0 + bj * cstep - offx);
                            *(u32x2*)gp = (u32x2){pack_fp8x4(v0[0], v0[1], v0[2], v0[3]), pack_fp8x4(v1[0], v1[1], v1[2], v1[3])};
                        } else {
                        u32x4 w; w.x = cvt_pk_bf16(v0[0], v0[1]); w.y = cvt_pk_bf16(v0[2], v0[3]); w.z = cvt_pk_bf16(v1[0], v1[1]); w.w = cvt_pk_bf16(v1[2], v1[3]);
                        *(u32x4*)(rp + bj * cstep) = w; }
                    }
                }
        }
    }
};

struct Epi2 {
    static constexpr bool PERM = true;
    const bf16_t* H; unsigned char* MG8; float oscale;
    __device__ __forceinline__ bool keep(const pg8::Unit& u) const { return u.part == 0; }
    __device__ __forceinline__ void operator()(f32x4 (&acc)[2][2][4][2], const pg8::Unit& u, int wr, int wc, int fr, int fq) const {
        const int row0 = u.pm * 256 + wr * 64 + fr, col0 = u.pn * 256 + wc * 32 + 8 * fq;
        if (u.part == 0) {
#pragma unroll
            for (int ai = 0; ai < 2; ++ai)
#pragma unroll
                for (int m = 0; m < 4; ++m) {
                    const bf16_t* hrow = H + (size_t)(row0 + ai * 128 + m * 16) * DIN;
#pragma unroll
                    for (int bj = 0; bj < 2; ++bj) {
                        const u32x2 sa = *(const u32x2*)((const unsigned char*)(hrow + OFF_MGA) + col0 + bj * 128), sb = *(const u32x2*)((const unsigned char*)(hrow + OFF_MGB) + col0 + bj * 128);
                        f32x4 a0, a1, b0, b1; unpack_fp8x8(sa, a0, a1); unpack_fp8x8(sb, b0, b1);
                        f32x4 r0, r1;
#pragma unroll
                        for (int e = 0; e < 4; ++e) { r0[e] = a0[e] * fast_rcp(fmaxf(b0[e], 1e-30f)); r1[e] = a1[e] * fast_rcp(fmaxf(b1[e], 1e-30f)); }
                        acc[ai][bj][m][0] *= r0; acc[ai][bj][m][1] *= r1;
                    }
                    if (m == 3) asm volatile("" ::: "memory");
                }
        } else {
#pragma unroll
            for (int ai = 0; ai < 2; ++ai)
#pragma unroll
                for (int m = 0; m < 4; ++m) {
                    const size_t rr = (size_t)(row0 + ai * 128 + m * 16);
                    const bf16_t* hrow = H + rr * DIN; unsigned char* op = MG8 + rr * D + col0;
#pragma unroll
                    for (int bj = 0; bj < 2; ++bj) {
                        const u32x2 sbw = *(const u32x2*)((const unsigned char*)(hrow + OFF_MGB) + col0 + bj * 128);
                        f32x4 b0, b1; unpack_fp8x8(sbw, b0, b1);
                        const f32x4 v0 = acc[ai][bj][m][0] * oscale * b0, v1 = acc[ai][bj][m][1] * oscale * b1;
                        const unsigned p0 = pack_fp8x4(v0[0], v0[1], v0[2], v0[3]), p1 = pack_fp8x4(v1[0], v1[1], v1[2], v1[3]);
                        *(u32x2*)(op + bj * 128) = (u32x2){p0, p1};
                    }
                    if (m == 3) asm volatile("" ::: "memory");
                }
        }
    }
};

struct Epi3 {
    static constexpr bool PERM = true;
    const float* x; _Float16* z16; f32x2* stats; float ascale;
    __device__ __forceinline__ bool keep(const pg8::Unit&) const { return false; }
    __device__ __forceinline__ void operator()(f32x4 (&acc)[2][2][4][2], const pg8::Unit& u, int wr, int wc, int fr, int fq) const {
        typedef _Float16 h8 __attribute__((ext_vector_type(8)));
        const int row0 = u.pm * 256 + wr * 64 + fr, col0 = u.pn * 256 + wc * 32 + 8 * fq;
#pragma unroll
        for (int ai = 0; ai < 2; ++ai)
#pragma unroll
            for (int m = 0; m < 4; ++m) {
                const int row = row0 + ai * 128 + m * 16; const size_t off = (size_t)row * D + col0;
                float s = 0.f, q = 0.f;
#pragma unroll
                for (int bj = 0; bj < 2; ++bj) {
                    const f32x4 x0 = *(const f32x4*)(x + off + bj * 128), x1 = *(const f32x4*)(x + off + bj * 128 + 4);
                    const f32x4 z0 = x0 * DN_ALPHA + acc[ai][bj][m][0] * ascale, z1 = x1 * DN_ALPHA + acc[ai][bj][m][1] * ascale;
                    *(h8*)(z16 + off + bj * 128) = (h8){(_Float16)z0[0], (_Float16)z0[1], (_Float16)z0[2], (_Float16)z0[3], (_Float16)z1[0], (_Float16)z1[1], (_Float16)z1[2], (_Float16)z1[3]};
                    s += ((z0[0] + z0[1]) + (z0[2] + z0[3])) + ((z1[0] + z1[1]) + (z1[2] + z1[3]));
                    q += ((z0[0] * z0[0] + z0[1] * z0[1]) + (z0[2] * z0[2] + z0[3] * z0[3])) + ((z1[0] * z1[0] + z1[1] * z1[1]) + (z1[2] * z1[2] + z1[3] * z1[3]));
                }
                s += __shfl_xor(s, 16); s += __shfl_xor(s, 32); q += __shfl_xor(q, 16); q += __shfl_xor(q, 32);
                if (fq == 0) stats[(size_t)row * 32 + u.pn * 4 + wc] = (f32x2){s, q};
                asm volatile("" ::: "memory");
            }
    }
};

__device__ __forceinline__ void transpose_item(const float* W, int N, bf16_t* WT, int ldt, int k0, int n_src, int n_dst, int kofs, LAS float* scr, int lane) {
    const int r8 = lane >> 3, c4 = lane & 7;
    f32x4 v[8];
#pragma unroll
    for (int i = 0; i < 8; ++i) v[i] = *(const f32x4*)(W + (size_t)(k0 + r8 + 8 * i) * N + n_src + 4 * c4);
#pragma unroll
    for (int i = 0; i < 8; ++i) { LAS float* d = scr + (r8 + 8 * i) * 33 + 4 * c4; d[0] = v[i][0]; d[1] = v[i][1]; d[2] = v[i][2]; d[3] = v[i][3]; }
    asm volatile("s_waitcnt lgkmcnt(0)" ::: "memory");
    const int c = lane & 7;
#pragma unroll
    for (int j = 0; j < 4; ++j) { const int n = (lane >> 3) + 8 * j; const LAS float* s = scr + (8 * c) * 33 + n;
        u32x4 o; o.x = cvt_pk_bf16(s[0 * 33], s[1 * 33]); o.y = cvt_pk_bf16(s[2 * 33], s[3 * 33]); o.z = cvt_pk_bf16(s[4 * 33], s[5 * 33]); o.w = cvt_pk_bf16(s[6 * 33], s[7 * 33]);
        *(u32x4*)(WT + (size_t)(n_dst + n) * ldt + kofs + k0 + 8 * c) = o; }
    asm volatile("s_waitcnt lgkmcnt(0)" ::: "memory");
}

__device__ __forceinline__ void transpose_item_fp8(const float* W, int N, unsigned char* W8, int pitch, int kofs, int k0, int n_src, int n_dst, float scale, LAS float* scr, int lane) {
    const int r8 = lane >> 3, c4 = lane & 7;
    f32x4 v[8];
#pragma unroll
    for (int i = 0; i < 8; ++i) v[i] = *(const f32x4*)(W + (size_t)(k0 + r8 + 8 * i) * N + n_src + 4 * c4);
#pragma unroll
    for (int i = 0; i < 8; ++i) { LAS float* d = scr + (r8 + 8 * i) * 33 + 4 * c4; d[0] = v[i][0]; d[1] = v[i][1]; d[2] = v[i][2]; d[3] = v[i][3]; }
    asm volatile("s_waitcnt lgkmcnt(0)" ::: "memory");
    const int n = lane & 31, cp = lane >> 5;
#pragma unroll
    for (int q = 0; q < 2; ++q) { const int ck = (2 * cp + q) * 16; const LAS float* sp = scr + ck * 33 + n; u32x4 o;
#pragma unroll
        for (int w = 0; w < 4; ++w) o[w] = pack_fp8x4(sp[(4 * w) * 33] * scale, sp[(4 * w + 1) * 33] * scale, sp[(4 * w + 2) * 33] * scale, sp[(4 * w + 3) * 33] * scale);
        *(u32x4*)(W8 + (size_t)(n_dst + n) * pitch + kofs + k0 + ck) = o; }
    asm volatile("s_waitcnt lgkmcnt(0)" ::: "memory");
}

template <int DH, bool IS_A>
__device__ __forceinline__ void attn_task(const LAS unsigned char* Kl, const LAS unsigned char* Vl, const bf16x8 (&qf)[DH / 32], const u32x2 (&gwv)[DH / 16], bf16_t* orow,
                                          int i0, int jlo, float sink2, float* lse_ptr, int lane, unsigned char* u8row) {
    constexpr int KS = (DH == 128) ? 288 : 160, VS = (DH == 128) ? 288 : 160, NKS = DH / 32, NDT = DH / 16;
    const int c16 = lane & 15, g = lane >> 4;
    f32x4 s[9];
    const LAS unsigned char* kp = Kl + (i0 + c16) * KS + 16 * g;
    bf16x8 kf[2][9];
#pragma unroll
    for (int T = 0; T < 9; ++T) { s[T] = (f32x4){0.f, 0.f, 0.f, 0.f}; kf[0][T] = *(const LAS bf16x8*)(kp + T * 16 * KS); }
#pragma unroll
    for (int ks = 0; ks < NKS; ++ks) {
        if (ks + 1 < NKS) {
#pragma unroll
            for (int T = 0; T < 9; ++T) kf[(ks + 1) & 1][T] = *(const LAS bf16x8*)(kp + T * 16 * KS + (ks + 1) * 64); }
        __builtin_amdgcn_sched_barrier(0);
#pragma unroll
        for (int T = 0; T < 9; ++T) s[T] = __builtin_amdgcn_mfma_f32_16x16x32_bf16(kf[ks & 1][T], qf[ks], s[T], 0, 0, 0);
        __builtin_amdgcn_sched_barrier(0);
    }
    const int i = i0 + c16; const int jmin = max(i + (IS_A ? 1 : 0), jlo), jmax = i + 128;
    float mx = -INFINITY;
#pragma unroll
    for (int T = 0; T < 9; ++T)
#pragma unroll
        for (int r = 0; r < 4; ++r) { const int j = i0 + 16 * T + 4 * g + r; const bool ok = (j >= jmin) && (j <= jmax); const float v = ok ? s[T][r] : -INFINITY; s[T][r] = v; mx = fmaxf(mx, v); }
    mx = fmaxf(mx, __shfl_xor(mx, 16)); mx = fmaxf(mx, __shfl_xor(mx, 32));
    if (IS_A) mx = fmaxf(mx, sink2);
    float sum = 0.f;
#pragma unroll
    for (int T = 0; T < 9; ++T)
#pragma unroll
        for (int r = 0; r < 4; ++r) { const float p = fast_exp2(s[T][r] - mx); s[T][r] = p; sum += p; }
    sum += __shfl_xor(sum, 16); sum += __shfl_xor(sum, 32);
    if (IS_A) sum += fast_exp2(sink2 - mx);
    bf16x8 pf[4];
#pragma unroll
    for (int k = 0; k < 4; ++k) { u32x4 w; w.x = cvt_pk_bf16(s[2 * k][0], s[2 * k][1]); w.y = cvt_pk_bf16(s[2 * k][2], s[2 * k][3]); w.z = cvt_pk_bf16(s[2 * k + 1][0], s[2 * k + 1][1]); w.w = cvt_pk_bf16(s[2 * k + 1][2], s[2 * k + 1][3]);
        pf[k] = __builtin_bit_cast(bf16x8, w); }
    bf16x4 p8; { u32x2 w; w.x = cvt_pk_bf16(s[8][0], s[8][1]); w.y = cvt_pk_bf16(s[8][2], s[8][3]); p8 = __builtin_bit_cast(bf16x4, w); }
    const int q4 = c16 >> 2, p4 = c16 & 3;
    const LAS unsigned char* vp = Vl + (i0 + 4 * g + q4) * VS + 8 * p4;
    const float inv = fast_rcp(sum);
    bf16x4 vv[2][9];
#pragma unroll
    for (int r9 = 0; r9 < 9; ++r9) vv[0][r9] = __builtin_amdgcn_ds_read_tr16_b64_v4i16((LAS bf16x4*)(vp + (16 * r9) * VS));
#pragma unroll
    for (int dt = 0; dt < NDT; ++dt) {
        if (dt + 1 < NDT) {
#pragma unroll
            for (int r9 = 0; r9 < 9; ++r9) vv[(dt + 1) & 1][r9] = __builtin_amdgcn_ds_read_tr16_b64_v4i16((LAS bf16x4*)(vp + (16 * r9) * VS + (dt + 1) * 32)); }
        __builtin_amdgcn_sched_barrier(0);
        f32x4 o = (f32x4){0.f, 0.f, 0.f, 0.f};
#pragma unroll
        for (int k = 0; k < 4; ++k) {
            const bf16x4 lo = vv[dt & 1][2 * k], hi = vv[dt & 1][2 * k + 1];
            o = __builtin_amdgcn_mfma_f32_16x16x32_bf16((bf16x8){lo[0], lo[1], lo[2], lo[3], hi[0], hi[1], hi[2], hi[3]}, pf[k], o, 0, 0, 0);
        }
        { const bf16x4 l8 = vv[dt & 1][8];
          o = __builtin_amdgcn_mfma_f32_16x16x32_bf16((bf16x8){l8[0], l8[1], l8[2], l8[3], l8[0], l8[1], l8[2], l8[3]}, (bf16x8){p8[0], p8[1], p8[2], p8[3], 0, 0, 0, 0}, o, 0, 0, 0); }
        __builtin_amdgcn_sched_barrier(0);
        o = o * inv;
        if (IS_A) { typedef float f2 __attribute__((ext_vector_type(2))); const f2 ga = __builtin_amdgcn_cvt_pk_f32_fp8((int)gwv[dt].x, false), gb = __builtin_amdgcn_cvt_pk_f32_fp8((int)gwv[dt].x, true);
            o[0] *= ga[0] * SU8; o[1] *= ga[1] * SU8; o[2] *= gb[0] * SU8; o[3] *= gb[1] * SU8;
            *(unsigned*)(u8row + 16 * dt + 4 * g) = pack_fp8x4(o[0], o[1], o[2], o[3]); }
        else *(unsigned*)((unsigned char*)orow + 16 * dt + 4 * g) = pack_fp8x4(o[0] * SU8, o[1] * SU8, o[2] * SU8, o[3] * SU8);
    }
    if (!IS_A) { if (g == 0) *lse_ptr = mx + __builtin_amdgcn_logf(sum); }
}

template <int DH>
__device__ __forceinline__ void load_kv(LAS unsigned char* Kl, LAS unsigned char* Vl, const bf16_t* Hk, const bf16_t* Hv, long tok0, int tstride, int jlo, int tid) {
    constexpr int KS = (DH == 128) ? 288 : 160, VS = (DH == 128) ? 288 : 160, CPR = DH / 8, PER = 256 * CPR / 512;
    u32x4 kv[PER], vv[PER];
#pragma unroll
    for (int c = 0; c < PER; ++c) { const int idx = c * 512 + tid, row = idx / CPR, ch = idx % CPR;
        if (row >= jlo) { const size_t off = (size_t)(tok0 + (long)row * tstride) * DIN + ch * 8; kv[c] = *(const u32x4*)(Hk + off); vv[c] = *(const u32x4*)(Hv + off); }
        else { kv[c] = (u32x4){0u, 0u, 0u, 0u}; vv[c] = (u32x4){0u, 0u, 0u, 0u}; } }
#pragma unroll
    for (int c = 0; c < PER; ++c) { const int idx = c * 512 + tid, row = idx / CPR, ch = idx % CPR;
        *(LAS u32x4*)(Kl + row * KS + ch * 16) = kv[c]; *(LAS u32x4*)(Vl + row * VS + ch * 16) = vv[c]; }
}


__device__ __forceinline__ void own_barrier(unsigned* cnt, unsigned G) {
    asm volatile("s_waitcnt vmcnt(0) lgkmcnt(0)" ::: "memory");
    __syncthreads();
    if (threadIdx.x == 0) {
        __builtin_amdgcn_fence(__ATOMIC_RELEASE, "agent"); asm volatile("s_waitcnt vmcnt(0)" ::: "memory");
        unsigned target;
        if ((G & 7u) == 0u) { target = 8u;
            const unsigned old = __hip_atomic_fetch_add(cnt + 64 * (1 + (blockIdx.x & 7)), 1u, __ATOMIC_RELAXED, __HIP_MEMORY_SCOPE_AGENT);
            if (old + 1u == (G >> 3)) __hip_atomic_fetch_add(cnt, 1u, __ATOMIC_RELAXED, __HIP_MEMORY_SCOPE_AGENT); }
        else { target = G; __hip_atomic_fetch_add(cnt, 1u, __ATOMIC_RELAXED, __HIP_MEMORY_SCOPE_AGENT); }
        unsigned spins = 0;
        while (__hip_atomic_load(cnt, __ATOMIC_RELAXED, __HIP_MEMORY_SCOPE_AGENT) < target && ++spins < (1u << 22)) __builtin_amdgcn_s_sleep(1);
        __builtin_amdgcn_fence(__ATOMIC_ACQUIRE, "agent"); asm volatile("s_waitcnt vmcnt(0)" ::: "memory");
    }
    __syncthreads();
}
#define GRID_SYNC() do { if (seam_no == 0) { asm volatile("s_waitcnt vmcnt(0) lgkmcnt(0)" ::: "memory"); grid.sync(); } else own_barrier((unsigned*)(ws + WS_CTL) + 1024 * seam_no, (unsigned)G); ++seam_no; } while (0)
struct Args {
    const float* x; const int* pos; const float* w_in; const float* b_gate; const float* sinks; const float* w_pa; const float* w_pb; const float* w_out; const float* ln_g; const float* ln_b;
    float* out; unsigned char* ws;
    float inv_freq[64];
    unsigned char tl_bf16[48], tl_fp8[48];
    int n_bf16, n_fp8; unsigned long long fp8mask;
};

__global__ void __launch_bounds__(512, 2) hybrid_fwd(Args a) {
    extern __shared__ __attribute__((aligned(16))) unsigned char lds_raw[];
    LAS unsigned char* lds = (LAS unsigned char*)lds_raw;
    cg::grid_group grid = cg::this_grid();
    int tid = threadIdx.x, lane = tid & 63; const int wave = __builtin_amdgcn_readfirstlane(tid >> 6);
    const int G = gridDim.x, bx = blockIdx.x;
#define PHASE_LOCAL() do { asm volatile("" : "+v"(tid)); lane = tid & 63; asm volatile("" : "+v"(lane)); } while (0)
    unsigned char* ws = a.ws; int seam_no = 0;
    bf16_t* XB = (bf16_t*)(ws + WS_XB); bf16_t* WinT = (bf16_t*)(ws + WS_WIN); bf16_t* WpT = (bf16_t*)(ws + WS_WP); bf16_t* WoutT = (bf16_t*)(ws + WS_WOUT);
    f32x2* csB = (f32x2*)(ws + WS_CSB); f32x2* csA = (f32x2*)(ws + WS_CSA); float* LSE = (float*)(ws + WS_LSE); f32x2* STATS = (f32x2*)(ws + WS_STATS);
    bf16_t* H = (bf16_t*)(ws + WS_H); bf16_t* MG = (bf16_t*)(ws + WS_XB);
    unsigned char* U8 = (unsigned char*)a.out + 32 * MiB;
    bf16_t* OG = (bf16_t*)((unsigned char*)a.out + 56 * MiB);
    unsigned char* U8_unused = (unsigned char*)a.out;
    unsigned char* MG8 = (unsigned char*)(ws + WS_XB);
    unsigned char* Wp8 = (unsigned char*)(ws + WS_WP); unsigned char* Wout8 = (unsigned char*)(ws + WS_WOUT);
    _Float16* Z16 = (_Float16*)(ws + WS_H);
    unsigned char* XB8 = (unsigned char*)a.out;

    if (bx == 0 && tid < 72) __hip_atomic_store((unsigned*)(ws + WS_CTL) + 1024 * (tid / 9) + 64 * (tid % 9), 0u, __ATOMIC_RELAXED, __HIP_MEMORY_SCOPE_AGENT);
    {
        const size_t gt = (size_t)bx * 512 + tid, GT = (size_t)G * 512;
        {
            const size_t NCH = (size_t)M * D / 8;
            for (size_t i0 = gt; i0 < NCH; i0 += 4 * GT) {
                f32x4 v[4][2];
#pragma unroll
                for (int u = 0; u < 4; ++u) { const size_t i = i0 + (size_t)u * GT; if (i < NCH) { v[u][0] = ((const f32x4*)a.x)[2 * i]; v[u][1] = ((const f32x4*)a.x)[2 * i + 1]; } }
#pragma unroll
                for (int u = 0; u < 4; ++u) { const size_t i = i0 + (size_t)u * GT; if (i < NCH) {
                    u32x4 w; w.x = cvt_pk_bf16(v[u][0][0], v[u][0][1]); w.y = cvt_pk_bf16(v[u][0][2], v[u][0][3]); w.z = cvt_pk_bf16(v[u][1][0], v[u][1][1]); w.w = cvt_pk_bf16(v[u][1][2], v[u][1][3]);
                    if (a.n_bf16 > 0) ((u32x4*)XB)[i] = w;
                    const unsigned p0 = pack_fp8x4(v[u][0][0], v[u][0][1], v[u][0][2], v[u][0][3]), p1 = pack_fp8x4(v[u][1][0], v[u][1][1], v[u][1][2], v[u][1][3]);
                    ((u32x2*)XB8)[i] = (u32x2){p0, p1}; } }
            }
        }
        for (size_t i = gt; i < (size_t)M * 64; i += GT) {
            const int t = (int)(i >> 6), j = (int)(i & 63);
            const float ang = (float)a.pos[t] * a.inv_freq[j];
            const double rev = (double)ang * 0.15915494309189535; const float fr = (float)(rev - __builtin_rint(rev));
            const f32x2 cs = (f32x2){__builtin_amdgcn_cosf(fr), __builtin_amdgcn_sinf(fr)};
            csB[i] = cs; if ((j & 1) == 0) csA[(size_t)t * 32 + (j >> 1)] = cs;
        }
        LAS float* scr = (LAS float*)(lds + wave * 16384);
        const int gw = bx * 8 + wave, NGW = G * 8;
        constexpr int I_IN = (D / 64) * (DIN / 32);
        for (int it = gw; it < I_IN; it += NGW) { const int nb = it % (DIN / 32), kb = it / (DIN / 32);
            if ((a.fp8mask >> (nb >> 3)) & 1ull) transpose_item_fp8(a.w_in, DIN, (unsigned char*)WinT, 4096, 0, 64 * kb, gemm_col_to_orig(32 * nb), 32 * nb, W8_SCALE, scr, lane);
            else transpose_item(a.w_in, DIN, WinT, D, 64 * kb, gemm_col_to_orig(32 * nb), 32 * nb, 0, scr, lane); }
    }
    GRID_SYNC();

    {
        if (a.n_fp8 > 0) {
            pg8::Gemm g{(const bf16_t*)XB8, WinT, D / 2, D}; pg8::OrderList S{M / 256, a.n_fp8, (M / 256) * a.n_fp8, G, bx, D / 128, a.tl_fp8};
            Epi1 E{H, csA, csB, a.b_gate, 0, 1.0f / W8_SCALE};
            pg8::gemm_phase<Epi1, pg8::OrderList, true>(lds, g, S, E);
        }
        {
            const int nwg = (M / 256) * (a.n_fp8 > 0 ? a.n_fp8 : a.n_bf16), rem = nwg % G; const int first = rem ? rem : 0, nhelp = G - first;
            if (bx >= first) {
                LAS float* scr = (LAS float*)(lds + wave * 16384);
                const int gw = (bx - first) * 8 + wave, NGW = nhelp * 8;
                constexpr int I_PA = (1024 / 64) * (D / 32), I_PB = (512 / 64) * (D / 32), I_OUT = (D / 64) * (D / 32);
                for (int it = gw; it < I_PA + I_PB + I_OUT; it += NGW) {
                    int r = it;
                    if (r < I_PA) { const int nb = r % (D / 32), kb = r / (D / 32); transpose_item_fp8(a.w_pa, D, Wp8, 1536, 0, 64 * kb, 32 * nb, 32 * nb, W8_SCALE, scr, lane); continue; } r -= I_PA;
                    if (r < I_PB) { const int nb = r % (D / 32), kb = r / (D / 32); transpose_item_fp8(a.w_pb, D, Wp8, 1536, 1024, 64 * kb, 32 * nb, 32 * nb, W8_SCALE, scr, lane); continue; } r -= I_PB;
                    { const int nb = r % (D / 32), kb = r / (D / 32); transpose_item_fp8(a.w_out, D, Wout8, 2048, 0, 64 * kb, 32 * nb, 32 * nb, W8_SCALE, scr, lane); }
                }
            }
        }
    }
    GRID_SYNC();

    {
        constexpr int N_A = 256, N_B = 1536;
        const bool xmap = (G % 8 == 0) && (N_A % 8 == 0) && (N_B % 8 == 0);
        const int xcd = bx & 7, jx = bx >> 3, perx = G >> 3;
        for (int i0 = bx; i0 < N_A + N_B; i0 += G) {
            int it = i0;
            if (xmap) { const int k = i0 / G;
                if (i0 < N_A) it = xcd * (N_A / 8) + k * perx + jx;
                else { const int kb = (i0 - N_A) / G; it = N_A + xcd * (N_B / 8) + kb * perx + jx; } }
            __syncthreads();
            if (it < N_A) {
                const int kvh = it & 1, b = it >> 1;
                LAS unsigned char* Kl = lds; LAS unsigned char* Vl = lds + 256 * 160;
                const int jlo = (b == 0) ? 128 : 0;
                load_kv<64>(Kl, Vl, H + OFF_KA + kvh * 64, H + OFF_VA + kvh * 64, (long)(b - 1) * 128, 1, jlo, tid);
                __syncthreads();
                const int head = kvh * 8 + wave; const float sink2 = a.sinks[head] * LOG2E;
                const int g4 = lane >> 4;
                bf16x8 qn[2]; u32x2 gn[4];
                { const size_t tok = (size_t)b * 128 + (lane & 15); const bf16_t* qr = H + tok * DIN + OFF_QA + head * 64; const bf16_t* gr = (const bf16_t*)((const unsigned char*)(H + tok * DIN + OFF_GA) + head * 64);
#pragma unroll
                  for (int ks = 0; ks < 2; ++ks) qn[ks] = *(const bf16x8*)(qr + ks * 32 + 8 * g4);
#pragma unroll
                  for (int dt = 0; dt < 4; ++dt) gn[dt] = (u32x2){*(const unsigned*)((const unsigned char*)gr + 16 * dt + 4 * g4), 0u}; }
                for (int c = 0; c < 8; ++c) {
                    const size_t tok = (size_t)b * 128 + c * 16 + (lane & 15);
                    const bf16x8 qc[2] = {qn[0], qn[1]}; const u32x2 gc[4] = {gn[0], gn[1], gn[2], gn[3]};
                    if (c < 7) { const size_t tn = tok + 16; const bf16_t* qr = H + tn * DIN + OFF_QA + head * 64; const bf16_t* gr = (const bf16_t*)((const unsigned char*)(H + tn * DIN + OFF_GA) + head * 64);
#pragma unroll
                        for (int ks = 0; ks < 2; ++ks) qn[ks] = *(const bf16x8*)(qr + ks * 32 + 8 * g4);
#pragma unroll
                        for (int dt = 0; dt < 4; ++dt) gn[dt] = (u32x2){*(const unsigned*)((const unsigned char*)gr + 16 * dt + 4 * g4), 0u}; }
                    attn_task<64, true>(Kl, Vl, qc, gc, nullptr, c * 16, jlo, sink2, nullptr, lane, U8 + tok * 1536 + head * 64);
                }
            } else {
                const int bi = it - N_A, grp = bi >> 9, rem = bi & 511, hs = rem >> 7, rb = rem & 127;
                const int dsh = 2 * grp, d = 1 << dsh;
                const int nblk = 128 >> dsh, r = rb / nblk, b = rb % nblk;
                LAS unsigned char* Kl = lds; LAS unsigned char* Vl = lds + 256 * 288;
                const int jlo = (b == 0) ? 128 : 0;
                const int colh = grp * 512 + hs * 128;
                load_kv<128>(Kl, Vl, H + OFF_KB + colh, H + OFF_VB + colh, ((long)(b - 1) * 128) * d + r, d, jlo, tid);
                __syncthreads();
                const size_t tok = ((size_t)b * 128 + wave * 16 + (lane & 15)) * d + r;
                const bf16_t* qrow = H + tok * DIN + OFF_QB + colh;
                bf16x8 qb4[4]; u32x2 gdum[8];
#pragma unroll
                for (int ks = 0; ks < 4; ++ks) qb4[ks] = *(const bf16x8*)(qrow + ks * 32 + 8 * (lane >> 4));
#pragma unroll
                for (int dt = 0; dt < 8; ++dt) gdum[dt] = (u32x2){0u, 0u};
                attn_task<128, false>(Kl, Vl, qb4, gdum, (bf16_t*)((unsigned char*)OG + ((size_t)grp * M + tok) * 512 + hs * 128), wave * 16, jlo, 0.f, LSE + ((size_t)grp * M + tok) * 4 + hs, lane, nullptr);
            }
        }
    }
    GRID_SYNC();

    {
        const int gw = bx * 8 + wave, NGW = G * 8;
        const int hs = lane >> 4, dc = (lane & 15) * 8;
        for (int t0 = gw; t0 < M; t0 += 2 * NGW) {
            float lw[2][3]; u32x2 ov[2][3], gv[2]; int tt[2];
#pragma unroll
            for (int u = 0; u < 2; ++u) { const int t = (t0 + u * NGW < M) ? t0 + u * NGW : t0; tt[u] = t;
                const bf16_t* hp = H + (size_t)t * DIN;
#pragma unroll
                for (int g3 = 0; g3 < 3; ++g3) { lw[u][g3] = LSE[((size_t)g3 * M + t) * 4 + hs]; ov[u][g3] = *(const u32x2*)((const unsigned char*)OG + ((size_t)g3 * M + t) * 512 + hs * 128 + dc); }
                gv[u] = *(const u32x2*)((const unsigned char*)(hp + OFF_GB) + hs * 128 + dc); }
#pragma unroll
            for (int u = 0; u < 2; ++u) {
                const float mxl = fmaxf(lw[u][0], fmaxf(lw[u][1], lw[u][2]));
                float w0 = fast_exp2(lw[u][0] - mxl), w1 = fast_exp2(lw[u][1] - mxl), w2 = fast_exp2(lw[u][2] - mxl);
                const float iw = fast_rcp(w0 + w1 + w2); w0 *= iw; w1 *= iw; w2 *= iw;
                f32x4 a0, a1, b0, b1, c0, c1, g0, g1;
                unpack_fp8x8(ov[u][0], a0, a1); unpack_fp8x8(ov[u][1], b0, b1); unpack_fp8x8(ov[u][2], c0, c1); unpack_fp8x8(gv[u], g0, g1);
                const f32x4 r0 = (a0 * w0 + b0 * w1 + c0 * w2) * g0, r1 = (a1 * w0 + b1 * w1 + c1 * w2) * g1;
                const unsigned p0 = pack_fp8x4(r0[0], r0[1], r0[2], r0[3]), p1 = pack_fp8x4(r1[0], r1[1], r1[2], r1[3]);
                if (u == 0 || tt[1] != tt[0]) *(u32x2*)(U8 + (size_t)tt[u] * 1536 + 1024 + hs * 128 + dc) = (u32x2){p0, p1};
            }
        }
    }
    GRID_SYNC();

    {
        pg8::Gemm g{(const bf16_t*)U8, (const bf16_t*)Wp8, 768, 768}; pg8::OrderTwoPart S{M / 256, D / 256, (M / 256) * (D / 256), G, bx, 512, 8, 4};
        Epi2 E{H, MG8, SM8 / (SU8 * W8_SCALE)};
        pg8::gemm_phase<Epi2, pg8::OrderTwoPart, true>(lds, g, S, E);
    }
    GRID_SYNC();

    {
        pg8::Gemm g{(const bf16_t*)MG8, (const bf16_t*)Wout8, D / 2, D / 2}; pg8::OrderPlain S{M / 256, D / 256, (M / 256) * (D / 256), G, bx, D / 128};
        Epi3 E{a.x, Z16, STATS, 1.0f / (SM8 * W8_SCALE)};
        pg8::gemm_phase<Epi3, pg8::OrderPlain, true>(lds, g, S, E);
    }
    GRID_SYNC();

    {
        const int xcd = bx & 7, cu_in_x = bx >> 3, per_x = G >> 3;
        const int gw = (G % 8 == 0) ? (cu_in_x * 8 + wave) : (bx * 8 + wave), NGW = (G % 8 == 0) ? per_x * 8 : G * 8;
        const int row_base = (G % 8 == 0) ? xcd * (M / 8) : 0, row_cnt = (G % 8 == 0) ? (M / 8) : M;
        typedef _Float16 h8 __attribute__((ext_vector_type(8)));
        f32x4 gg[8], bb[8];
#pragma unroll
        for (int j = 0; j < 4; ++j) { gg[2 * j] = *(const f32x4*)(a.ln_g + 512 * j + 8 * lane); gg[2 * j + 1] = *(const f32x4*)(a.ln_g + 512 * j + 8 * lane + 4);
                                      bb[2 * j] = *(const f32x4*)(a.ln_b + 512 * j + 8 * lane); bb[2 * j + 1] = *(const f32x4*)(a.ln_b + 512 * j + 8 * lane + 4); }
        for (int tl = gw; tl < row_cnt; tl += 4 * NGW) {
            int tr[4]; f32x2 pr[4]; h8 zz[4][4];
#pragma unroll
            for (int u = 0; u < 4; ++u) { tr[u] = (tl + u * NGW < row_cnt) ? row_base + tl + u * NGW : row_base + tl;
                pr[u] = (lane < 32) ? STATS[(size_t)tr[u] * 32 + lane] : (f32x2){0.f, 0.f};
#pragma unroll
                for (int j = 0; j < 4; ++j) zz[u][j] = *(const h8*)(Z16 + (size_t)tr[u] * D + 512 * j + 8 * lane); }
#pragma unroll
            for (int u = 0; u < 4; ++u) {
                float s0 = pr[u].x, q0 = pr[u].y;
#pragma unroll
                for (int o = 1; o < 64; o <<= 1) { s0 += __shfl_xor(s0, o); q0 += __shfl_xor(q0, o); }
                const float m0 = s0 * (1.0f / D); const float r0 = 1.0f / sqrtf(fmaxf(q0 * (1.0f / D) - m0 * m0, 0.f) + LN_EPS);
                if (u == 0 || tr[u] != tr[0]) { float* o0 = a.out + (size_t)tr[u] * D + 8 * lane;
#pragma unroll
                    for (int j = 0; j < 4; ++j) {
                        const f32x4 a0 = (f32x4){(float)zz[u][j][0], (float)zz[u][j][1], (float)zz[u][j][2], (float)zz[u][j][3]}, a1 = (f32x4){(float)zz[u][j][4], (float)zz[u][j][5], (float)zz[u][j][6], (float)zz[u][j][7]};
                        *(f32x4*)(o0 + 512 * j) = (a0 - m0) * r0 * gg[2 * j] + bb[2 * j]; *(f32x4*)(o0 + 512 * j + 4) = (a1 - m0) * r0 * gg[2 * j + 1] + bb[2 * j + 1];
                    } }
            }
        }
    }
}

extern "C" void kernel_launch(void* const* d_in, const int* in_sizes, int n_in, void* d_out, int out_size, void* d_ws, size_t ws_size, hipStream_t stream) {
    static int grid = 0;
    if (grid == 0) {
        if (n_in != 10 || in_sizes[0] != M * D || out_size != M * D || ws_size < WS_END) { fprintf(stderr, "kernel_launch: unexpected shapes (n_in %d, in0 %d, out %d, ws %zu); nothing launched\n", n_in, n_in > 0 ? in_sizes[0] : -1, out_size, ws_size); grid = -1; return; }
        int dev = 0, cus = 0, per_cu = 0;
        hipGetDevice(&dev); hipDeviceGetAttribute(&cus, hipDeviceAttributeMultiprocessorCount, dev);
        if (hipFuncSetAttribute((const void*)hybrid_fwd, hipFuncAttributeMaxDynamicSharedMemorySize, LDS_BYTES) != hipSuccess) { fprintf(stderr, "kernel_launch: hipFuncSetAttribute failed\n"); grid = -1; return; }
        if (hipOccupancyMaxActiveBlocksPerMultiprocessor(&per_cu, (const void*)hybrid_fwd, 512, LDS_BYTES) != hipSuccess || per_cu < 1) { fprintf(stderr, "kernel_launch: occupancy query says %d blocks per CU\n", per_cu); per_cu = 1; }
        (void)hipGetLastError();
        grid = cus * 1;
    }
    if (grid < 0) return;
    Args a{};
    a.x = (const float*)d_in[0]; a.pos = (const int*)d_in[1]; a.w_in = (const float*)d_in[2]; a.b_gate = (const float*)d_in[3]; a.sinks = (const float*)d_in[4];
    a.w_pa = (const float*)d_in[5]; a.w_pb = (const float*)d_in[6]; a.w_out = (const float*)d_in[7]; a.ln_g = (const float*)d_in[8]; a.ln_b = (const float*)d_in[9];
    a.out = (float*)d_out; a.ws = (unsigned char*)d_ws;
    {
        for (int pn = 0; pn < DIN / 256; ++pn) { const bool f8 = true;
            if (f8) { a.tl_fp8[a.n_fp8++] = (unsigned char)pn; a.fp8mask |= 1ull << pn; } else a.tl_bf16[a.n_bf16++] = (unsigned char)pn; }
    }
    for (int j = 0; j < 64; ++j) a.inv_freq[j] = (float)pow(10000.0, -(double)j / 64.0);
    void* args[] = {&a};
    hipError_t e = hipLaunchCooperativeKernel((const void*)hybrid_fwd, dim3(grid), dim3(512), args, LDS_BYTES, stream);
    if (e != hipSuccess) fprintf(stderr, "kernel_launch: cooperative launch failed: %s (grid %d)\n", hipGetErrorString(e), grid);
}
```

```cpp
#include <hip/hip_runtime.h>
#include <hip/hip_cooperative_groups.h>
#include <cstdio>
#include <cstdint>
#include <cmath>
namespace cg = cooperative_groups;

#define LAS __attribute__((address_space(3)))
typedef unsigned short bf16_t;
typedef short bf16x8 __attribute__((ext_vector_type(8)));
typedef short bf16x4 __attribute__((ext_vector_type(4)));
typedef float f32x4 __attribute__((ext_vector_type(4)));
typedef float f32x2 __attribute__((ext_vector_type(2)));
typedef unsigned u32x4 __attribute__((ext_vector_type(4)));
typedef unsigned u32x2 __attribute__((ext_vector_type(2)));

constexpr int M = 16384, D = 2048, DIN = 11520;
constexpr int OFF_QA = 0, OFF_KA = 1024, OFF_VA = 1152, OFF_GA = 1280, OFF_QB = 2304, OFF_KB = 3840, OFF_VB = 5376, OFF_GB = 6912, OFF_MGA = 7424, OFF_MGB = 9472;
constexpr int OFF_UB = 1024;
constexpr float LOG2E = 1.4426950408889634f;
constexpr float SC_QA = 0.125f * LOG2E;
constexpr float SC_QB = 0.08838834764831845f * LOG2E;
constexpr float DN_ALPHA = 1.189207115002721f;
constexpr float LN_EPS = 1e-5f;
constexpr float W8_SCALE = 64.0f;
constexpr float SU8 = 16.0f, SM8 = 32.0f;
constexpr size_t MiB = 1u << 20;
constexpr size_t WS_XB = 0;
constexpr size_t WS_WIN = 64 * MiB;
constexpr size_t WS_WP = 110 * MiB;
constexpr size_t WS_WOUT = 116 * MiB;
constexpr size_t WS_CSB = 124 * MiB;
constexpr size_t WS_CSA = 132 * MiB;
constexpr size_t WS_LSE = 136 * MiB;
constexpr size_t WS_STATS = 137 * MiB;
constexpr size_t WS_CTL = 142 * MiB;
constexpr size_t WS_H = 144 * MiB;
constexpr size_t WS_END = 504 * MiB;
constexpr int LDS_BYTES = 147456;

__device__ __forceinline__ unsigned cvt_pk_bf16(float lo, float hi) { unsigned r; asm volatile("v_cvt_pk_bf16_f32 %0, %1, %2" : "=v"(r) : "v"(lo), "v"(hi)); return r; }
__device__ __forceinline__ float bf_lo(unsigned w) { return __uint_as_float(w << 16); }
__device__ __forceinline__ float bf_hi(unsigned w) { return __uint_as_float(w & 0xffff0000u); }
__device__ __forceinline__ float fast_rcp(float x) { return __builtin_amdgcn_rcpf(x); }
__device__ __forceinline__ float fast_exp2(float x) { return __builtin_amdgcn_exp2f(x); }
__device__ __forceinline__ float sigmoidf_(float v) { return fast_rcp(1.0f + fast_exp2(-v * LOG2E)); }

__device__ __forceinline__ unsigned pack_fp8x4(float a, float b, float c, float d) {
    const unsigned lo = (unsigned)__builtin_amdgcn_cvt_pk_fp8_f32(a, b, 0, false), hi = (unsigned)__builtin_amdgcn_cvt_pk_fp8_f32(c, d, 0, false);
    return (lo & 0xffffu) | (hi << 16);
}

__device__ __forceinline__ void unpack_fp8x8(u32x2 w, f32x4& lo, f32x4& hi) {
    typedef float f2 __attribute__((ext_vector_type(2)));
    const f2 a = __builtin_amdgcn_cvt_pk_f32_fp8((int)w.x, false), b = __builtin_amdgcn_cvt_pk_f32_fp8((int)w.x, true), c = __builtin_amdgcn_cvt_pk_f32_fp8((int)w.y, false), d = __builtin_amdgcn_cvt_pk_f32_fp8((int)w.y, true);
    lo = (f32x4){a[0], a[1], b[0], b[1]}; hi = (f32x4){c[0], c[1], d[0], d[1]};
}

namespace pg8 {
constexpr int BM = 256, BK = 64, HALF = 128, HTB = HALF * BK * 2, STAGE_BYTES = 8 * HTB, NXCD = 8, WGM = 2;
__host__ __device__ __forceinline__ int lds_byte(int r, int c) { const int st = (r >> 4) * 2 + (c >> 5), rr = r & 15, cc = c & 31, ob = rr * 64 + cc * 2; return st * 1024 + (ob ^ (((ob >> 9) & 1) << 5)); }
__host__ __device__ __forceinline__ void stage_rc(int b, int& R, int& C) { const int st = b / 1024, sb = b % 1024, swz = sb ^ (((sb >> 9) & 1) << 5); R = (st >> 1) * 16 + swz / 64; C = (st & 1) * 32 + (swz % 64) / 2; }
__host__ __device__ __forceinline__ int perm32(int rho) { const int n = rho >> 4, i = rho & 15; return 8 * (i >> 2) + 4 * n + (i & 3); }

typedef int v8i_t __attribute__((ext_vector_type(8))); typedef int v4i_t __attribute__((ext_vector_type(4)));
__device__ __forceinline__ v8i_t join8(bf16x8 lo, bf16x8 hi) { const v4i_t a = __builtin_bit_cast(v4i_t, lo), b = __builtin_bit_cast(v4i_t, hi); return __builtin_shufflevector(a, b, 0, 1, 2, 3, 4, 5, 6, 7); }
struct Unit { int pm, pn, k0, nt, part; };
struct Gemm { const bf16_t* A; const bf16_t* Bt; int lda, ldb; };

__device__ __forceinline__ void tile_of(int L, int nM, int nN, int& pm, int& pn) {
    const int nwg = nM * nN; int wgid = L;
    { const int q = nwg / NXCD, r = nwg % NXCD, xcd = wgid % NXCD, off = wgid / NXCD; wgid = (xcd < r ? xcd * (q + 1) : r * (q + 1) + (xcd - r) * q) + off; }
    const int nig = WGM * nN, gid = wgid / nig, fm = gid * WGM, gsz = (nM - fm) < WGM ? (nM - fm) : WGM;
    pm = fm + ((wgid % nig) % gsz); pn = (wgid % nig) / gsz;
}
struct OrderPlain {
    int nM, nN, nwg, G, c, nt;
    __device__ __forceinline__ bool next(int i, Unit& u) const { const long L = (long)i * G + c; if (L >= nwg) return false; tile_of((int)L, nM, nN, u.pm, u.pn); u.k0 = 0; u.nt = nt; u.part = 0; return true; }
};
struct OrderList {
    int nM, nN, nwg, G, c, nt; const unsigned char* list;
    __device__ __forceinline__ bool next(int i, Unit& u) const { const long L = (long)i * G + c; if (L >= nwg) return false; int j; tile_of((int)L, nM, nN, u.pm, j); u.pn = list[j]; u.k0 = 0; u.nt = nt; u.part = 0; return true; }
};
struct OrderTwoPart {
    int nM, nN, nwg, G, c, k1, nt0, nt1;
    __device__ __forceinline__ bool next(int i, Unit& u) const { const long L = (long)(i >> 1) * G + c; if (L >= nwg) return false; tile_of((int)L, nM, nN, u.pm, u.pn);
        u.part = i & 1; u.k0 = u.part ? k1 : 0; u.nt = u.part ? nt1 : nt0; return true; }
};

template <class Epi, class Sched, bool FP8 = false>
__device__ __forceinline__ void gemm_phase(LAS unsigned char* lds, const Gemm g, const Sched& S, const Epi& E) {
    const int tid = threadIdx.x;
    const int wid = __builtin_amdgcn_readfirstlane(tid >> 6), lane = tid & 63, wr = wid >> 2, wc = wid & 3, fr = lane & 15, fq = lane >> 4;
    unsigned voffA[2], voffB[2];
#pragma unroll
    for (int i = 0; i < 2; ++i) { int R, C; stage_rc(tid * 16 + i * 8192, R, C); const int Rb = Epi::PERM ? ((R & ~31) + perm32(R & 31)) : R;
        voffA[i] = (unsigned)(R * g.lda + C) * 2u; voffB[i] = (unsigned)(Rb * g.ldb + C) * 2u; }
    const size_t kstep = (size_t)(BK * 2);
    const size_t hstepA = (size_t)HALF * g.lda * 2, hstepB = (size_t)HALF * g.ldb * 2;
    const size_t tstepA = 2 * hstepA, tstepB = 2 * hstepB;
    const unsigned ldsw = (unsigned)wid * 1024u;
    const int aoff = lds_byte(wr * 64 + fr, fq * 8), boff = lds_byte(wc * 32 + fr, fq * 8);
#define PG8_SA(b, h) (((b) * 2 + (h)) * HTB)
#define PG8_SB(b, h) ((4 + (b) * 2 + (h)) * HTB)
#define PG8_STAGE(bufoff, gbase, voff) do { _Pragma("unroll") for (int _i = 0; _i < 2; ++_i) \
        __builtin_amdgcn_global_load_lds((const unsigned*)((const char*)(gbase) + (voff)[_i]), (LAS unsigned*)(lds + (bufoff) + ldsw + _i * 8192), 16, 0, 0); } while (0)
#define PG8_LDA(dst, b, h) do { _Pragma("unroll") for (int m = 0; m < 4; ++m) { \
        if constexpr (FP8) dst##8[m] = join8(*(const LAS bf16x8*)(lds + PG8_SA(b, h) + aoff + m * 2048), *(const LAS bf16x8*)(lds + PG8_SA(b, h) + aoff + m * 2048 + 1024)); \
        else { _Pragma("unroll") for (int k = 0; k < 2; ++k) dst[m][k] = *(const LAS bf16x8*)(lds + PG8_SA(b, h) + aoff + m * 2048 + k * 1024); } } } while (0)
#define PG8_LDB(dst, b, h) do { _Pragma("unroll") for (int n = 0; n < 2; ++n) { \
        if constexpr (FP8) dst##8[n] = join8(*(const LAS bf16x8*)(lds + PG8_SB(b, h) + boff + n * 2048), *(const LAS bf16x8*)(lds + PG8_SB(b, h) + boff + n * 2048 + 1024)); \
        else { _Pragma("unroll") for (int k = 0; k < 2; ++k) dst[n][k] = *(const LAS bf16x8*)(lds + PG8_SB(b, h) + boff + n * 2048 + k * 1024); } } } while (0)
#define PG8_MMA(ai, bj, At, Bt) do { __builtin_amdgcn_s_setprio(1); \
        if constexpr (FP8) { _Pragma("unroll") for (int m = 0; m < 4; ++m) _Pragma("unroll") for (int n = 0; n < 2; ++n) \
            asm volatile("v_mfma_scale_f32_16x16x128_f8f6f4 %0, %1, %2, %0, %3, %3 op_sel_hi:[0,0,0]" : "+v"(acc[ai][bj][m][n]) : "v"(Bt##8[n]), "v"(At##8[m]), "v"(fp8_one)); } \
        else { _Pragma("unroll") for (int m = 0; m < 4; ++m) _Pragma("unroll") for (int n = 0; n < 2; ++n) _Pragma("unroll") for (int k = 0; k < 2; ++k) \
            acc[ai][bj][m][n] = __builtin_amdgcn_mfma_f32_16x16x32_bf16(Bt[n][k], At[m][k], acc[ai][bj][m][n], 0, 0, 0); } \
        __builtin_amdgcn_s_setprio(0); } while (0)
#define PG8_WAIT_V(n) asm volatile("s_waitcnt vmcnt(" #n ")" ::: "memory")
#define PG8_WAIT_L(n) asm volatile("s_waitcnt lgkmcnt(" #n ")" ::: "memory")
#define PG8_BAR __builtin_amdgcn_s_barrier()
#define PG8_SCHED __builtin_amdgcn_sched_barrier(0)
    Unit cur, nxt; int ui = 0;
    if (!S.next(0, cur)) return;
    f32x4 acc[2][2][4][2];
#pragma unroll
    for (int a = 0; a < 2; ++a)
#pragma unroll
        for (int b = 0; b < 2; ++b)
#pragma unroll
            for (int m = 0; m < 4; ++m)
#pragma unroll
                for (int n = 0; n < 2; ++n) acc[a][b][m][n] = (f32x4){0.f, 0.f, 0.f, 0.f};
    const int fp8_one = 0x7F7F7F7F;
    bf16x8 At[4][2], B0[2][2], B1[2][2]; v8i_t At8[4], B08[2], B18[2];
    const char* cA = (const char*)g.A + (size_t)cur.pm * tstepA + (size_t)cur.k0 * 2; const char* cB = (const char*)g.Bt + (size_t)cur.pn * tstepB + (size_t)cur.k0 * 2;
    PG8_STAGE(PG8_SB(0, 0), cB, voffB); PG8_STAGE(PG8_SB(0, 1), cB + hstepB, voffB); PG8_STAGE(PG8_SA(0, 0), cA, voffA); PG8_STAGE(PG8_SA(0, 1), cA + hstepA, voffA);
    if (wr == 1) PG8_BAR;
    PG8_WAIT_V(2); PG8_BAR;
    PG8_STAGE(PG8_SB(1, 0), cB + kstep, voffB); PG8_STAGE(PG8_SA(1, 0), cA + kstep, voffA); PG8_STAGE(PG8_SB(1, 1), cB + hstepB + kstep, voffB);
    PG8_WAIT_V(6); PG8_BAR;
    for (;;) {
        const bool has_next = S.next(ui + 1, nxt);
        const char* nA = has_next ? (const char*)g.A + (size_t)nxt.pm * tstepA + (size_t)nxt.k0 * 2 : cA; const char* nB = has_next ? (const char*)g.Bt + (size_t)nxt.pn * tstepB + (size_t)nxt.k0 * 2 : cB;
        const int nt = cur.nt;
        for (int t = 0; t < nt; t += 2) {
            const bool last = (t == nt - 2);
            const char* a1 = cA + (size_t)(t + 1) * kstep;
            const char* a2 = last ? nA : cA + (size_t)(t + 2) * kstep; const char* b2 = last ? nB : cB + (size_t)(t + 2) * kstep;
            const char* a3 = a2 + kstep; const char* b3 = b2 + kstep;
            PG8_LDB(B0, 0, 0); PG8_LDB(B1, 0, 1); PG8_SCHED; PG8_LDA(At, 0, 0); PG8_STAGE(PG8_SA(1, 1), a1 + hstepA, voffA);
            PG8_WAIT_V(8); PG8_WAIT_L(0); PG8_BAR; PG8_MMA(0, 0, At, B0); PG8_MMA(0, 1, At, B1); PG8_BAR; PG8_SCHED;
            PG8_LDA(At, 0, 1); PG8_STAGE(PG8_SB(0, 0), b2, voffB); PG8_STAGE(PG8_SB(0, 1), b2 + hstepB, voffB); PG8_STAGE(PG8_SA(0, 0), a2, voffA);
            PG8_WAIT_V(8); PG8_WAIT_L(0); PG8_BAR; PG8_MMA(1, 0, At, B0); PG8_MMA(1, 1, At, B1); PG8_BAR; PG8_SCHED;
            PG8_LDB(B0, 1, 0); PG8_LDB(B1, 1, 1); PG8_SCHED; PG8_LDA(At, 1, 0); PG8_STAGE(PG8_SA(0, 1), a2 + hstepA, voffA);
            PG8_WAIT_V(8); PG8_WAIT_L(0); PG8_BAR; PG8_MMA(0, 0, At, B0); PG8_MMA(0, 1, At, B1); PG8_BAR; PG8_SCHED;
            PG8_LDA(At, 1, 1); PG8_STAGE(PG8_SB(1, 0), b3, voffB); PG8_STAGE(PG8_SB(1, 1), b3 + hstepB, voffB); PG8_STAGE(PG8_SA(1, 0), a3, voffA);
            PG8_WAIT_V(8); PG8_WAIT_L(0); PG8_BAR; PG8_MMA(1, 0, At, B0); PG8_MMA(1, 1, At, B1); PG8_BAR; PG8_SCHED;
        }
        if (wr == 0) PG8_BAR;
        if constexpr (FP8) asm volatile("s_nop 15\n\ts_nop 15" ::: "memory");
        E(acc, cur, wr, wc, fr, fq);
        if (!has_next) break;
        if (!E.keep(cur)) {
#pragma unroll
            for (int a = 0; a < 2; ++a)
#pragma unroll
                for (int b = 0; b < 2; ++b)
#pragma unroll
                    for (int m = 0; m < 4; ++m)
#pragma unroll
                        for (int n = 0; n < 2; ++n) acc[a][b][m][n] = (f32x4){0.f, 0.f, 0.f, 0.f};
        }
        cur = nxt; cA = nA; cB = nB; ++ui;
        if (wr == 1) PG8_BAR;
    }
    PG8_WAIT_V(0);
    PG8_BAR;
#undef PG8_SA
#undef PG8_SB
#undef PG8_STAGE
#undef PG8_LDA
#undef PG8_LDB
#undef PG8_MMA
#undef PG8_WAIT_V
#undef PG8_WAIT_L
#undef PG8_BAR
#undef PG8_SCHED
}
}

__host__ __device__ __forceinline__ int tile_mode(int pn) { return (pn <= 4) ? 1 : (pn >= 9 && pn <= 20) ? 2 : 0; }
__host__ __device__ __forceinline__ int gemm_col_to_orig(int nprime) {
    const int pn = nprime >> 8, xp = nprime & 255, bj = xp >> 7, x = xp & 127, md = tile_mode(pn);
    if (md == 1) return 256 * pn + 64 * (x >> 5) + (x & 31) + 32 * bj;
    if (md == 2) return 256 * pn + 128 * (x >> 6) + (x & 63) + 64 * bj;
    return nprime;
}

struct Epi1 {
    static constexpr bool PERM = true;
    bf16_t* H; const f32x2* csA; const f32x2* csB; const float* bgate; int pn_off; float ascale;
    __device__ __forceinline__ bool keep(const pg8::Unit&) const { return false; }
    __device__ __forceinline__ void operator()(f32x4 (&acc)[2][2][4][2], const pg8::Unit& u, int wr, int wc, int fr, int fq) const {
        const int pn = u.pn + pn_off, md = tile_mode(pn);
        const int row0 = u.pm * 256 + wr * 64 + fr;
        int col0, cstep;
        if (md == 1) { col0 = 256 * pn + 64 * wc + 8 * fq; cstep = 32; }
        else if (md == 2) { col0 = 256 * pn + 128 * (wc >> 1) + 32 * (wc & 1) + 8 * fq; cstep = 64; }
        else { col0 = 256 * pn + 32 * wc + 8 * fq; cstep = 128; }
        const bool rope = (md == 2) || (md == 1 && (pn < 4 || wc < 2));
        if (rope) {
            const float sc = ((pn < 4) ? SC_QA : (pn >= 9 && pn < 15) ? SC_QB : 1.0f) * ascale;
#pragma unroll
            for (int ai = 0; ai < 2; ++ai)
#pragma unroll
                for (int m = 0; m < 4; ++m) {
                    const int row = row0 + ai * 128 + m * 16;
                    const f32x4* cp = (md == 1) ? (const f32x4*)(csA + (size_t)row * 32 + 8 * fq) : (const f32x4*)(csB + (size_t)row * 64 + 32 * (wc & 1) + 8 * fq);
                    const f32x4 t0 = cp[0], t1 = cp[1], t2 = cp[2], t3 = cp[3];
                    const f32x4 a0 = acc[ai][0][m][0], a1 = acc[ai][0][m][1], b0 = acc[ai][1][m][0], b1 = acc[ai][1][m][1];
                    u32x4 w0, w1;
                    w0.x = cvt_pk_bf16((a0[0] * t0[0] - b0[0] * t0[1]) * sc, (a0[1] * t0[2] - b0[1] * t0[3]) * sc);
                    w0.y = cvt_pk_bf16((a0[2] * t1[0] - b0[2] * t1[1]) * sc, (a0[3] * t1[2] - b0[3] * t1[3]) * sc);
                    w0.z = cvt_pk_bf16((a1[0] * t2[0] - b1[0] * t2[1]) * sc, (a1[1] * t2[2] - b1[1] * t2[3]) * sc);
                    w0.w = cvt_pk_bf16((a1[2] * t3[0] - b1[2] * t3[1]) * sc, (a1[3] * t3[2] - b1[3] * t3[3]) * sc);
                    w1.x = cvt_pk_bf16((b0[0] * t0[0] + a0[0] * t0[1]) * sc, (b0[1] * t0[2] + a0[1] * t0[3]) * sc);
                    w1.y = cvt_pk_bf16((b0[2] * t1[0] + a0[2] * t1[1]) * sc, (b0[3] * t1[2] + a0[3] * t1[3]) * sc);
                    w1.z = cvt_pk_bf16((b1[0] * t2[0] + a1[0] * t2[1]) * sc, (b1[1] * t2[2] + a1[1] * t2[3]) * sc);
                    w1.w = cvt_pk_bf16((b1[2] * t3[0] + a1[2] * t3[1]) * sc, (b1[3] * t3[2] + a1[3] * t3[3]) * sc);
                    bf16_t* rp = H + (size_t)row * DIN + col0;
                    *(u32x4*)(rp) = w0; *(u32x4*)(rp + cstep) = w1;
                    if (m == 3) asm volatile("" ::: "memory");
                }
        } else {
            const int act = (pn >= 29) ? 2 : ((pn >= 5 && pn <= 8) || pn == 27 || pn == 28) ? 1 : 0;
            f32x4 bv[2][2];
#pragma unroll
            for (int bj = 0; bj < 2; ++bj)
#pragma unroll
                for (int n = 0; n < 2; ++n) bv[bj][n] = (act == 2) ? *(const f32x4*)(bgate + (col0 + bj * cstep - OFF_MGA) + 4 * n) : (f32x4){0.f, 0.f, 0.f, 0.f};
#pragma unroll
            for (int ai = 0; ai < 2; ++ai)
#pragma unroll
                for (int m = 0; m < 4; ++m) {
                    bf16_t* rp = H + (size_t)(row0 + ai * 128 + m * 16) * DIN + col0;
#pragma unroll
                    for (int bj = 0; bj < 2; ++bj) {
                        f32x4 v0 = acc[ai][bj][m][0] * ascale + bv[bj][0], v1 = acc[ai][bj][m][1] * ascale + bv[bj][1];
                        if (act == 1) {
#pragma unroll
                            for (int j = 0; j < 4; ++j) { v0[j] = v0[j] * sigmoidf_(v0[j]); v1[j] = v1[j] * sigmoidf_(v1[j]); } }
                        else if (act == 2) {
#pragma unroll
                            for (int j = 0; j < 4; ++j) { v0[j] = sigmoidf_(v0[j]); v1[j] = sigmoidf_(v1[j]); } }
                        if (act != 0) {
                            const int offx = (pn >= 37) ? OFF_MGB : (pn >= 29) ? OFF_MGA : (pn >= 27) ? OFF_GB : OFF_GA;
                            unsigned char* gp = (unsigned char*)(H + (size_t)(row0 + ai * 128 + m * 16) * DIN + offx) + (col0 + bj * cstep - offx);
                            *(u32x2*)gp = (u32x2){pack_fp8x4(v0[0], v0[1], v0[2], v0[3]), pack_fp8x4(v1[0], v1[1], v1[2], v1[3])};
                        } else {
                        u32x4 w; w.x = cvt_pk_bf16(v0[0], v0[1]); w.y = cvt_pk_bf16(v0[2], v0[3]); w.z = cvt_pk_bf16(v1[0], v1[1]); w.w = cvt_pk_bf16(v1[2], v1[3]);
                        *(u32x4*)(rp + bj * cstep) = w; }
                    }
                }
        }
    }
};

struct Epi2 {
    static constexpr bool PERM = true;
    const bf16_t* H; unsigned char* MG8; float oscale;
    __device__ __forceinline__ bool keep(const pg8::Unit& u) const { return u.part == 0; }
    __device__ __forceinline__ void operator()(f32x4 (&acc)[2][2][4][2], const pg8::Unit& u, int wr, int wc, int fr, int fq) const {
        const int row0 = u.pm * 256 + wr * 64 + fr, col0 = u.pn * 256 + wc * 32 + 8 * fq;
        if (u.part == 0) {
#pragma unroll
            for (int ai = 0; ai < 2; ++ai)
#pragma unroll
                for (int m = 0; m < 4; ++m) {
                    const bf16_t* hrow = H + (size_t)(row0 + ai * 128 + m * 16) * DIN;
#pragma unroll
                    for (int bj = 0; bj < 2; ++bj) {
                        const u32x2 sa = *(const u32x2*)((const unsigned char*)(hrow + OFF_MGA) + col0 + bj * 128), sb = *(const u32x2*)((const unsigned char*)(hrow + OFF_MGB) + col0 + bj * 128);
                        f32x4 a0, a1, b0, b1; unpack_fp8x8(sa, a0, a1); unpack_fp8x8(sb, b0, b1);
                        f32x4 r0, r1;
#pragma unroll
                        for (int e = 0; e < 4; ++e) { r0[e] = a0[e] * fast_rcp(fmaxf(b0[e], 1e-30f)); r1[e] = a1[e] * fast_rcp(fmaxf(b1[e], 1e-30f)); }
                        acc[ai][bj][m][0] *= r0; acc[ai][bj][m][1] *= r1;
                    }
                    if (m == 3) asm volatile("" ::: "memory");
                }
        } else {
#pragma unroll
            for (int ai = 0; ai < 2; ++ai)
#pragma unroll
                for (int m = 0; m < 4; ++m) {
                    const size_t rr = (size_t)(row0 + ai * 128 + m * 16);
                    const bf16_t* hrow = H + rr * DIN; unsigned char* op = MG8 + rr * D + col0;
#pragma unroll
                    for (int bj = 0; bj < 2; ++bj) {
                        const u32x2 sbw = *(const u32x2*)((const unsigned char*)(hrow + OFF_MGB) + col0 + bj * 128);
                        f32x4 b0, b1; unpack_fp8x8(sbw, b0, b1);
                        const f32x4 v0 = acc[ai][bj][m][0] * oscale * b0, v1 = acc[ai][bj][m][1] * oscale * b1;
                        const unsigned p0 = pack_fp8x4(v0[0], v0[1], v0[2], v0[3]), p1 = pack_fp8x4(v1[0], v1[1], v1[2], v1[3]);
                        *(u32x2*)(op + bj * 128) = (u32x2){p0, p1};
                    }
                    if (m == 3) asm volatile("" ::: "memory");
                }
        }
    }
};

struct Epi3 {
    static constexpr bool PERM = true;
    const float* x; _Float16* z16; f32x2* stats; float ascale;
    __device__ __forceinline__ bool keep(const pg8::Unit&) const { return false; }
    __device__ __forceinline__ void operator()(f32x4 (&acc)[2][2][4][2], const pg8::Unit& u, int wr, int wc, int fr, int fq) const {
        typedef _Float16 h8 __attribute__((ext_vector_type(8)));
        const int row0 = u.pm * 256 + wr * 64 + fr, col0 = u.pn * 256 + wc * 32 + 8 * fq;
#pragma unroll
        for (int ai = 0; ai < 2; ++ai)
#pragma unroll
            for (int m = 0; m < 4; ++m) {
                const int row = row0 + ai * 128 + m * 16; const size_t off = (size_t)row * D + col0;
                float s = 0.f, q = 0.f;
#pragma unroll
                for (int bj = 0; bj < 2; ++bj) {
                    const f32x4 x0 = *(const f32x4*)(x + off + bj * 128), x1 = *(const f32x4*)(x + off + bj * 128 + 4);
                    const f32x4 z0 = x0 * DN_ALPHA + acc[ai][bj][m][0] * ascale, z1 = x1 * DN_ALPHA + acc[ai][bj][m][1] * ascale;
                    *(h8*)(z16 + off + bj * 128) = (h8){(_Float16)z0[0], (_Float16)z0[1], (_Float16)z0[2], (_Float16)z0[3], (_Float16)z1[0], (_Float16)z1[1], (_Float16)z1[2], (_Float16)z1[3]};
                    s += ((z0[0] + z0[1]) + (z0[2] + z0[3])) + ((z1[0] + z1[1]) + (z1[2] + z1[3]));
                    q += ((z0[0] * z0[0] + z0[1] * z0[1]) + (z0[2] * z0[2] + z0[3] * z0[3])) + ((z1[0] * z1[0] + z1[1] * z1[1]) + (z1[2] * z1[2] + z1[3] * z1[3]));
                }
                s += __shfl_xor(s, 16); s += __shfl_xor(s, 32); q += __shfl_xor(q, 16); q += __shfl_xor(q, 32);
                if (fq == 0) stats[(size_t)row * 32 + u.pn * 4 + wc] = (f32x2){s, q};
                asm volatile("" ::: "memory");
            }
    }
};

__device__ __forceinline__ void transpose_item(const float* W, int N, bf16_t* WT, int ldt, int k0, int n_src, int n_dst, int kofs, LAS float* scr, int lane) {
    const int r8 = lane >> 3, c4 = lane & 7;
    f32x4 v[8];
#pragma unroll
    for (int i = 0; i < 8; ++i) v[i] = *(const f32x4*)(W + (size_t)(k0 + r8 + 8 * i) * N + n_src + 4 * c4);
#pragma unroll
    for (int i = 0; i < 8; ++i) { LAS float* d = scr + (r8 + 8 * i) * 33 + 4 * c4; d[0] = v[i][0]; d[1] = v[i][1]; d[2] = v[i][2]; d[3] = v[i][3]; }
    asm volatile("s_waitcnt lgkmcnt(0)" ::: "memory");
    const int c = lane & 7;
#pragma unroll
    for (int j = 0; j < 4; ++j) { const int n = (lane >> 3) + 8 * j; const LAS float* s = scr + (8 * c) * 33 + n;
        u32x4 o; o.x = cvt_pk_bf16(s[0 * 33], s[1 * 33]); o.y = cvt_pk_bf16(s[2 * 33], s[3 * 33]); o.z = cvt_pk_bf16(s[4 * 33], s[5 * 33]); o.w = cvt_pk_bf16(s[6 * 33], s[7 * 33]);
        *(u32x4*)(WT + (size_t)(n_dst + n) * ldt + kofs + k0 + 8 * c) = o; }
    asm volatile("s_waitcnt lgkmcnt(0)" ::: "memory");
}

__device__ __forceinline__ void transpose_item_fp8(const float* W, int N, unsigned char* W8, int pitch, int kofs, int k0, int n_src, int n_dst, float scale, LAS float* scr, int lane) {
    const int r8 = lane >> 3, c4 = lane & 7;
    f32x4 v[8];
#pragma unroll
    for (int i = 0; i < 8; ++i) v[i] = *(const f32x4*)(W + (size_t)(k0 + r8 + 8 * i) * N + n_src + 4 * c4);
#pragma unroll
    for (int i = 0; i < 8; ++i) { LAS float* d = scr + (r8 + 8 * i) * 33 + 4 * c4; d[0] = v[i][0]; d[1] = v[i][1]; d[2] = v[i][2]; d[3] = v[i][3]; }
    asm volatile("s_waitcnt lgkmcnt(0)" ::: "memory");
    const int n = lane & 31, cp = lane >> 5;
#pragma unroll
    for (int q = 0; q < 2; ++q) { const int ck = (2 * cp + q) * 16; const LAS float* sp = scr + ck * 33 + n; u32x4 o;
#pragma unroll
        for (int w = 0; w < 4; ++w) o[w] = pack_fp8x4(sp[(4 * w) * 33] * scale, sp[(4 * w + 1) * 33] * scale, sp[(4 * w + 2) * 33] * scale, sp[(4 * w + 3) * 33] * scale);
        *(u32x4*)(W8 + (size_t)(n_dst + n) * pitch + kofs + k0 + ck) = o; }
    asm volatile("s_waitcnt lgkmcnt(0)" ::: "memory");
}

template <int DH, bool IS_A>
__device__ __forceinline__ void attn_task(const LAS unsigned char* Kl, const LAS unsigned char* Vl, const bf16x8 (&qf)[DH / 32], const u32x2 (&gwv)[DH / 16], bf16_t* orow,
                                          int i0, int jlo, float sink2, float* lse_ptr, int lane, unsigned char* u8row) {
    constexpr int KS = (DH == 128) ? 288 : 160, VS = (DH == 128) ? 288 : 160, NKS = DH / 32, NDT = DH / 16;
    const int c16 = lane & 15, g = lane >> 4;
    f32x4 s[9];
    const LAS unsigned char* kp = Kl + (i0 + c16) * KS + 16 * g;
    bf16x8 kf[2][9];
#pragma unroll
    for (int T = 0; T < 9; ++T) { s[T] = (f32x4){0.f, 0.f, 0.f, 0.f}; kf[0][T] = *(const LAS bf16x8*)(kp + T * 16 * KS); }
#pragma unroll
    for (int ks = 0; ks < NKS; ++ks) {
        if (ks + 1 < NKS) {
#pragma unroll
            for (int T = 0; T < 9; ++T) kf[(ks + 1) & 1][T] = *(const LAS bf16x8*)(kp + T * 16 * KS + (ks + 1) * 64); }
        __builtin_amdgcn_sched_barrier(0);
#pragma unroll
        for (int T = 0; T < 9; ++T) s[T] = __builtin_amdgcn_mfma_f32_16x16x32_bf16(kf[ks & 1][T], qf[ks], s[T], 0, 0, 0);
        __builtin_amdgcn_sched_barrier(0);
    }
    const int i = i0 + c16; const int jmin = max(i + (IS_A ? 1 : 0), jlo), jmax = i + 128;
    float mx = -INFINITY;
#pragma unroll
    for (int T = 0; T < 9; ++T)
#pragma unroll
        for (int r = 0; r < 4; ++r) { const int j = i0 + 16 * T + 4 * g + r; const bool ok = (j >= jmin) && (j <= jmax); const float v = ok ? s[T][r] : -INFINITY; s[T][r] = v; mx = fmaxf(mx, v); }
    mx = fmaxf(mx, __shfl_xor(mx, 16)); mx = fmaxf(mx, __shfl_xor(mx, 32));
    if (IS_A) mx = fmaxf(mx, sink2);
    float sum = 0.f;
#pragma unroll
    for (int T = 0; T < 9; ++T)
#pragma unroll
        for (int r = 0; r < 4; ++r) { const float p = fast_exp2(s[T][r] - mx); s[T][r] = p; sum += p; }
    sum += __shfl_xor(sum, 16); sum += __shfl_xor(sum, 32);
    if (IS_A) sum += fast_exp2(sink2 - mx);
    bf16x8 pf[4];
#pragma unroll
    for (int k = 0; k < 4; ++k) { u32x4 w; w.x = cvt_pk_bf16(s[2 * k][0], s[2 * k][1]); w.y = cvt_pk_bf16(s[2 * k][2], s[2 * k][3]); w.z = cvt_pk_bf16(s[2 * k + 1][0], s[2 * k + 1][1]); w.w = cvt_pk_bf16(s[2 * k + 1][2], s[2 * k + 1][3]);
        pf[k] = __builtin_bit_cast(bf16x8, w); }
    bf16x4 p8; { u32x2 w; w.x = cvt_pk_bf16(s[8][0], s[8][1]); w.y = cvt_pk_bf16(s[8][2], s[8][3]); p8 = __builtin_bit_cast(bf16x4, w); }
    const int q4 = c16 >> 2, p4 = c16 & 3;
    const LAS unsigned char* vp = Vl + (i0 + 4 * g + q4) * VS + 8 * p4;
    const float inv = fast_rcp(sum);
    bf16x4 vv[2][9];
#pragma unroll
    for (int r9 = 0; r9 < 9; ++r9) vv[0][r9] = __builtin_amdgcn_ds_read_tr16_b64_v4i16((LAS bf16x4*)(vp + (16 * r9) * VS));
#pragma unroll
    for (int dt = 0; dt < NDT; ++dt) {
        if (dt + 1 < NDT) {
#pragma unroll
            for (int r9 = 0; r9 < 9; ++r9) vv[(dt + 1) & 1][r9] = __builtin_amdgcn_ds_read_tr16_b64_v4i16((LAS bf16x4*)(vp + (16 * r9) * VS + (dt + 1) * 32)); }
        __builtin_amdgcn_sched_barrier(0);
        f32x4 o = (f32x4){0.f, 0.f, 0.f, 0.f};
#pragma unroll
        for (int k = 0; k < 4; ++k) {
            const bf16x4 lo = vv[dt & 1][2 * k], hi = vv[dt & 1][2 * k + 1];
            o = __builtin_amdgcn_mfma_f32_16x16x32_bf16((bf16x8){lo[0], lo[1], lo[2], lo[3], hi[0], hi[1], hi[2], hi[3]}, pf[k], o, 0, 0, 0);
        }
        { const bf16x4 l8 = vv[dt & 1][8];
          o = __builtin_amdgcn_mfma_f32_16x16x32_bf16((bf16x8){l8[0], l8[1], l8[2], l8[3], l8[0], l8[1], l8[2], l8[3]}, (bf16x8){p8[0], p8[1], p8[2], p8[3], 0, 0, 0, 0}, o, 0, 0, 0); }
        __builtin_amdgcn_sched_barrier(0);
        o = o * inv;
        if (IS_A) { typedef float f2 __attribute__((ext_vector_type(2))); const f2 ga = __builtin_amdgcn_cvt_pk_f32_fp8((int)gwv[dt].x, false), gb = __builtin_amdgcn_cvt_pk_f32_fp8((int)gwv[dt].x, true);
            o[0] *= ga[0] * SU8; o[1] *= ga[1] * SU8; o[2] *= gb[0] * SU8; o[3] *= gb[1] * SU8;
            *(unsigned*)(u8row + 16 * dt + 4 * g) = pack_fp8x4(o[0], o[1], o[2], o[3]); }
        else *(unsigned*)((unsigned char*)orow + 16 * dt + 4 * g) = pack_fp8x4(o[0] * SU8, o[1] * SU8, o[2] * SU8, o[3] * SU8);
    }
    if (!IS_A) { if (g == 0) *lse_ptr = mx + __builtin_amdgcn_logf(sum); }
}

template <int DH>
__device__ __forceinline__ void load_kv(LAS unsigned char* Kl, LAS unsigned char* Vl, const bf16_t* Hk, const bf16_t* Hv, long tok0, int tstride, int jlo, int tid) {
    constexpr int KS = (DH == 128) ? 288 : 160, VS = (DH == 128) ? 288 : 160, CPR = DH / 8, PER = 256 * CPR / 512;
    u32x4 kv[PER], vv[PER];
#pragma unroll
    for (int c = 0; c < PER; ++c) { const int idx = c * 512 + tid, row = idx / CPR, ch = idx % CPR;
        if (row >= jlo) { const size_t off = (size_t)(tok0 + (long)row * tstride) * DIN + ch * 8; kv[c] = *(const u32x4*)(Hk + off); vv[c] = *(const u32x4*)(Hv + off); }
        else { kv[c] = (u32x4){0u, 0u, 0u, 0u}; vv[c] = (u32x4){0u, 0u, 0u, 0u}; } }
#pragma unroll
    for (int c = 0; c < PER; ++c) { const int idx = c * 512 + tid, row = idx / CPR, ch = idx % CPR;
        *(LAS u32x4*)(Kl + row * KS + ch * 16) = kv[c]; *(LAS u32x4*)(Vl + row * VS + ch * 16) = vv[c]; }
}


__device__ __forceinline__ void own_barrier(unsigned* cnt, unsigned G) {
    asm volatile("s_waitcnt vmcnt(0) lgkmcnt(0)" ::: "memory");
    __syncthreads();
    if (threadIdx.x == 0) {
        __builtin_amdgcn_fence(__ATOMIC_RELEASE, "agent"); asm volatile("s_waitcnt vmcnt(0)" ::: "memory");
        unsigned target;
        if ((G & 7u) == 0u) { target = 8u;
            const unsigned old = __hip_atomic_fetch_add(cnt + 64 * (1 + (blockIdx.x & 7)), 1u, __ATOMIC_RELAXED, __HIP_MEMORY_SCOPE_AGENT);
            if (old + 1u == (G >> 3)) __hip_atomic_fetch_add(cnt, 1u, __ATOMIC_RELAXED, __HIP_MEMORY_SCOPE_AGENT); }
        else { target = G; __hip_atomic_fetch_add(cnt, 1u, __ATOMIC_RELAXED, __HIP_MEMORY_SCOPE_AGENT); }
        unsigned spins = 0;
        while (__hip_atomic_load(cnt, __ATOMIC_RELAXED, __HIP_MEMORY_SCOPE_AGENT) < target && ++spins < (1u << 22)) __builtin_amdgcn_s_sleep(1);
        __builtin_amdgcn_fence(__ATOMIC_ACQUIRE, "agent"); asm volatile("s_waitcnt vmcnt(0)" ::: "memory");
    }
    __syncthreads();
}
#define GRID_SYNC() do { if (seam_no == 0) { asm volatile("s_waitcnt vmcnt(0) lgkmcnt(0)" ::: "memory"); grid.sync(); } else own_barrier((unsigned*)(ws + WS_CTL) + 1024 * seam_no, (unsigned)G); ++seam_no; } while (0)
struct Args {
    const float* x; const int* pos; const float* w_in; const float* b_gate; const float* sinks; const float* w_pa; const float* w_pb; const float* w_out; const float* ln_g; const float* ln_b;
    float* out; unsigned char* ws;
    float inv_freq[64];
    unsigned char tl_bf16[48], tl_fp8[48];
    int n_bf16, n_fp8; unsigned long long fp8mask;
};

__global__ void __launch_bounds__(512, 2) hybrid_fwd(Args a) {
    extern __shared__ __attribute__((aligned(16))) unsigned char lds_raw[];
    LAS unsigned char* lds = (LAS unsigned char*)lds_raw;
    cg::grid_group grid = cg::this_grid();
    int tid = threadIdx.x, lane = tid & 63; const int wave = __builtin_amdgcn_readfirstlane(tid >> 6);
    const int G = gridDim.x, bx = blockIdx.x;
#define PHASE_LOCAL() do { asm volatile("" : "+v"(tid)); lane = tid & 63; asm volatile("" : "+v"(lane)); } while (0)
    unsigned char* ws = a.ws; int seam_no = 0;
    bf16_t* XB = (bf16_t*)(ws + WS_XB); bf16_t* WinT = (bf16_t*)(ws + WS_WIN); bf16_t* WpT = (bf16_t*)(ws + WS_WP); bf16_t* WoutT = (bf16_t*)(ws + WS_WOUT);
    f32x2* csB = (f32x2*)(ws + WS_CSB); f32x2* csA = (f32x2*)(ws + WS_CSA); float* LSE = (float*)(ws + WS_LSE); f32x2* STATS = (f32x2*)(ws + WS_STATS);
    bf16_t* H = (bf16_t*)(ws + WS_H); bf16_t* MG = (bf16_t*)(ws + WS_XB);
    unsigned char* U8 = (unsigned char*)a.out + 32 * MiB;
    bf16_t* OG = (bf16_t*)((unsigned char*)a.out + 56 * MiB);
    unsigned char* U8_unused = (unsigned char*)a.out;
    unsigned char* MG8 = (unsigned char*)(ws + WS_XB);
    unsigned char* Wp8 = (unsigned char*)(ws + WS_WP); unsigned char* Wout8 = (unsigned char*)(ws + WS_WOUT);
    _Float16* Z16 = (_Float16*)(ws + WS_H);
    unsigned char* XB8 = (unsigned char*)a.out;

    if (bx == 0 && tid < 72) __hip_atomic_store((unsigned*)(ws + WS_CTL) + 1024 * (tid / 9) + 64 * (tid % 9), 0u, __ATOMIC_RELAXED, __HIP_MEMORY_SCOPE_AGENT);
    {
        const size_t gt = (size_t)bx * 512 + tid, GT = (size_t)G * 512;
        {
            const size_t NCH = (size_t)M * D / 8;
            for (size_t i0 = gt; i0 < NCH; i0 += 4 * GT) {
                f32x4 v[4][2];
#pragma unroll
                for (int u = 0; u < 4; ++u) { const size_t i = i0 + (size_t)u * GT; if (i < NCH) { v[u][0] = ((const f32x4*)a.x)[2 * i]; v[u][1] = ((const f32x4*)a.x)[2 * i + 1]; } }
#pragma unroll
                for (int u = 0; u < 4; ++u) { const size_t i = i0 + (size_t)u * GT; if (i < NCH) {
                    u32x4 w; w.x = cvt_pk_bf16(v[u][0][0], v[u][0][1]); w.y = cvt_pk_bf16(v[u][0][2], v[u][0][3]); w.z = cvt_pk_bf16(v[u][1][0], v[u][1][1]); w.w = cvt_pk_bf16(v[u][1][2], v[u][1][3]);
                    if (a.n_bf16 > 0) ((u32x4*)XB)[i] = w;
                    const unsigned p0 = pack_fp8x4(v[u][0][0], v[u][0][1], v[u][0][2], v[u][0][3]), p1 = pack_fp8x4(v[u][1][0], v[u][1][1], v[u][1][2], v[u][1][3]);
                    ((u32x2*)XB8)[i] = (u32x2){p0, p1}; } }
            }
        }
        for (size_t i = gt; i < (size_t)M * 64; i += GT) {
            const int t = (int)(i >> 6), j = (int)(i & 63);
            const float ang = (float)a.pos[t] * a.inv_freq[j];
            const double rev = (double)ang * 0.15915494309189535; const float fr = (float)(rev - __builtin_rint(rev));
            const f32x2 cs = (f32x2){__builtin_amdgcn_cosf(fr), __builtin_amdgcn_sinf(fr)};
            csB[i] = cs; if ((j & 1) == 0) csA[(size_t)t * 32 + (j >> 1)] = cs;
        }
        LAS float* scr = (LAS float*)(lds + wave * 16384);
        const int gw = bx * 8 + wave, NGW = G * 8;
        constexpr int I_IN = (D / 64) * (DIN / 32);
        for (int it = gw; it < I_IN; it += NGW) { const int nb = it % (DIN / 32), kb = it / (DIN / 32);
            if ((a.fp8mask >> (nb >> 3)) & 1ull) transpose_item_fp8(a.w_in, DIN, (unsigned char*)WinT, 4096, 0, 64 * kb, gemm_col_to_orig(32 * nb), 32 * nb, W8_SCALE, scr, lane);
            else transpose_item(a.w_in, DIN, WinT, D, 64 * kb, gemm_col_to_orig(32 * nb), 32 * nb, 0, scr, lane); }
    }
    GRID_SYNC();

    {
        if (a.n_fp8 > 0) {
            pg8::Gemm g{(const bf16_t*)XB8, WinT, D / 2, D}; pg8::OrderList S{M / 256, a.n_fp8, (M / 256) * a.n_fp8, G, bx, D / 128, a.tl_fp8};
            Epi1 E{H, csA, csB, a.b_gate, 0, 1.0f / W8_SCALE};
            pg8::gemm_phase<Epi1, pg8::OrderList, true>(lds, g, S, E);
        }
        {
            const int nwg = (M / 256) * (a.n_fp8 > 0 ? a.n_fp8 : a.n_bf16), rem = nwg % G; const int first = rem ? rem : 0, nhelp = G - first;
            if (bx >= first) {
                LAS float* scr = (LAS float*)(lds + wave * 16384);
                const int gw = (bx - first) * 8 + wave, NGW = nhelp * 8;
                constexpr int I_PA = (1024 / 64) * (D / 32), I_PB = (512 / 64) * (D / 32), I_OUT = (D / 64) * (D / 32);
                for (int it = gw; it < I_PA + I_PB + I_OUT; it += NGW) {
                    int r = it;
                    if (r < I_PA) { const int nb = r % (D / 32), kb = r / (D / 32); transpose_item_fp8(a.w_pa, D, Wp8, 1536, 0, 64 * kb, 32 * nb, 32 * nb, W8_SCALE, scr, lane); continue; } r -= I_PA;
                    if (r < I_PB) { const int nb = r % (D / 32), kb = r / (D / 32); transpose_item_fp8(a.w_pb, D, Wp8, 1536, 1024, 64 * kb, 32 * nb, 32 * nb, W8_SCALE, scr, lane); continue; } r -= I_PB;
                    { const int nb = r % (D / 32), kb = r / (D / 32); transpose_item_fp8(a.w_out, D, Wout8, 2048, 0, 64 * kb, 32 * nb, 32 * nb, W8_SCALE, scr, lane); }
                }
            }
        }
    }
    GRID_SYNC();

    {
        constexpr int N_A = 256, N_B = 1536;
        const bool xmap = (G % 8 == 0) && (N_A % 8 == 0) && (N_B % 8 == 0);
        const int xcd = bx & 7, jx = bx >> 3, perx = G >> 3;
        for (int i0 = bx; i0 < N_A + N_B; i0 += G) {
            int it = i0;
            if (xmap) { const int k = i0 / G;
                if (i0 < N_A) it = xcd * (N_A / 8) + k * perx + jx;
                else { const int kb = (i0 - N_A) / G; it = N_A + xcd * (N_B / 8) + kb * perx + jx; } }
            __syncthreads();
            if (it < N_A) {
                const int kvh = it & 1, b = it >> 1;
                LAS unsigned char* Kl = lds; LAS unsigned char* Vl = lds + 256 * 160;
                const int jlo = (b == 0) ? 128 : 0;
                load_kv<64>(Kl, Vl, H + OFF_KA + kvh * 64, H + OFF_VA + kvh * 64, (long)(b - 1) * 128, 1, jlo, tid);
                __syncthreads();
                const int head = kvh * 8 + wave; const float sink2 = a.sinks[head] * LOG2E;
                const int g4 = lane >> 4;
                bf16x8 qn[2]; u32x2 gn[4];
                { const size_t tok = (size_t)b * 128 + (lane & 15); const bf16_t* qr = H + tok * DIN + OFF_QA + head * 64; const bf16_t* gr = (const bf16_t*)((const unsigned char*)(H + tok * DIN + OFF_GA) + head * 64);
#pragma unroll
                  for (int ks = 0; ks < 2; ++ks) qn[ks] = *(const bf16x8*)(qr + ks * 32 + 8 * g4);
#pragma unroll
                  for (int dt = 0; dt < 4; ++dt) gn[dt] = (u32x2){*(const unsigned*)((const unsigned char*)gr + 16 * dt + 4 * g4), 0u}; }
                for (int c = 0; c < 8; ++c) {
                    const size_t tok = (size_t)b * 128 + c * 16 + (lane & 15);
                    const bf16x8 qc[2] = {qn[0], qn[1]}; const u32x2 gc[4] = {gn[0], gn[1], gn[2], gn[3]};
                    if (c < 7) { const size_t tn = tok + 16; const bf16_t* qr = H + tn * DIN + OFF_QA + head * 64; const bf16_t* gr = (const bf16_t*)((const unsigned char*)(H + tn * DIN + OFF_GA) + head * 64);
#pragma unroll
                        for (int ks = 0; ks < 2; ++ks) qn[ks] = *(const bf16x8*)(qr + ks * 32 + 8 * g4);
#pragma unroll
                        for (int dt = 0; dt < 4; ++dt) gn[dt] = (u32x2){*(const unsigned*)((const unsigned char*)gr + 16 * dt + 4 * g4), 0u}; }
                    attn_task<64, true>(Kl, Vl, qc, gc, nullptr, c * 16, jlo, sink2, nullptr, lane, U8 + tok * 1536 + head * 64);
                }
            } else {
                const int bi = it - N_A, grp = bi >> 9, rem = bi & 511, hs = rem >> 7, rb = rem & 127;
                const int dsh = 2 * grp, d = 1 << dsh;
                const int nblk = 128 >> dsh, r = rb / nblk, b = rb % nblk;
                LAS unsigned char* Kl = lds; LAS unsigned char* Vl = lds + 256 * 288;
                const int jlo = (b == 0) ? 128 : 0;
                const int colh = grp * 512 + hs * 128;
                load_kv<128>(Kl, Vl, H + OFF_KB + colh, H + OFF_VB + colh, ((long)(b - 1) * 128) * d + r, d, jlo, tid);
                __syncthreads();
                const size_t tok = ((size_t)b * 128 + wave * 16 + (lane & 15)) * d + r;
                const bf16_t* qrow = H + tok * DIN + OFF_QB + colh;
                bf16x8 qb4[4]; u32x2 gdum[8];
#pragma unroll
                for (int ks = 0; ks < 4; ++ks) qb4[ks] = *(const bf16x8*)(qrow + ks * 32 + 8 * (lane >> 4));
#pragma unroll
                for (int dt = 0; dt < 8; ++dt) gdum[dt] = (u32x2){0u, 0u};
                attn_task<128, false>(Kl, Vl, qb4, gdum, (bf16_t*)((unsigned char*)OG + ((size_t)grp * M + tok) * 512 + hs * 128), wave * 16, jlo, 0.f, LSE + ((size_t)grp * M + tok) * 4 + hs, lane, nullptr);
            }
        }
    }
    GRID_SYNC();

    {
        const int gw = bx * 8 + wave, NGW = G * 8;
        const int hs = lane >> 4, dc = (lane & 15) * 8;
        for (int t0 = gw; t0 < M; t0 += 2 * NGW) {
            float lw[2][3]; u32x2 ov[2][3], gv[2]; int tt[2];
#pragma unroll
            for (int u = 0; u < 2; ++u) { const int t = (t0 + u * NGW < M) ? t0 + u * NGW : t0; tt[u] = t;
                const bf16_t* hp = H + (size_t)t * DIN;
#pragma unroll
                for (int g3 = 0; g3 < 3; ++g3) { lw[u][g3] = LSE[((size_t)g3 * M + t) * 4 + hs]; ov[u][g3] = *(const u32x2*)((const unsigned char*)OG + ((size_t)g3 * M + t) * 512 + hs * 128 + dc); }
                gv[u] = *(const u32x2*)((const unsigned char*)(hp + OFF_GB) + hs * 128 + dc); }
#pragma unroll
            for (int u = 0; u < 2; ++u) {
                const float mxl = fmaxf(lw[u][0], fmaxf(lw[u][1], lw[u][2]));
                float w0 = fast_exp2(lw[u][0] - mxl), w1 = fast_exp2(lw[u][1] - mxl), w2 = fast_exp2(lw[u][2] - mxl);
                const float iw = fast_rcp(w0 + w1 + w2); w0 *= iw; w1 *= iw; w2 *= iw;
                f32x4 a0, a1, b0, b1, c0, c1, g0, g1;
                unpack_fp8x8(ov[u][0], a0, a1); unpack_fp8x8(ov[u][1], b0, b1); unpack_fp8x8(ov[u][2], c0, c1); unpack_fp8x8(gv[u], g0, g1);
                const f32x4 r0 = (a0 * w0 + b0 * w1 + c0 * w2) * g0, r1 = (a1 * w0 + b1 * w1 + c1 * w2) * g1;
                const unsigned p0 = pack_fp8x4(r0[0], r0[1], r0[2], r0[3]), p1 = pack_fp8x4(r1[0], r1[1], r1[2], r1[3]);
                if (u == 0 || tt[1] != tt[0]) *(u32x2*)(U8 + (size_t)tt[u] * 1536 + 1024 + hs * 128 + dc) = (u32x2){p0, p1};
            }
        }
    }
    GRID_SYNC();

    {
        pg8::Gemm g{(const bf16_t*)U8, (const bf16_t*)Wp8, 768, 768}; pg8::OrderTwoPart S{M / 256, D / 256, (M / 256) * (D / 256), G, bx, 512, 8, 4};
        Epi2 E{H, MG8, SM8 / (SU8 * W8_SCALE)};
        pg8::gemm_phase<Epi2, pg8::OrderTwoPart, true>(lds, g, S, E);
    }
    GRID_SYNC();

    {
        pg8::Gemm g{(const bf16_t*)MG8, (const bf16_t*)Wout8, D / 2, D / 2}; pg8::OrderPlain S{M / 256, D / 256, (M / 256) * (D / 256), G, bx, D / 128};
        Epi3 E{a.x, Z16, STATS, 1.0f / (SM8 * W8_SCALE)};
        pg8::gemm_phase<Epi3, pg8::OrderPlain, true>(lds, g, S, E);
    }
    GRID_SYNC();

    {
        const int xcd = bx & 7, cu_in_x = bx >> 3, per_x = G >> 3;
        const int gw = (G % 8 == 0) ? (cu_in_x * 8 + wave) : (bx * 8 + wave), NGW = (G % 8 == 0) ? per_x * 8 : G * 8;
        const int row_base = (G % 8 == 0) ? xcd * (M / 8) : 0, row_cnt = (G % 8 == 0) ? (M / 8) : M;
        typedef _Float16 h8 __attribute__((ext_vector_type(8)));
        for (int tl = gw; tl < row_cnt; tl += 8 * NGW) {
            int tr[8]; f32x2 pr[8]; h8 zz[8][4];
#pragma unroll
            for (int u = 0; u < 8; ++u) { tr[u] = (tl + u * NGW < row_cnt) ? row_base + tl + u * NGW : row_base + tl;
                pr[u] = (lane < 32) ? STATS[(size_t)tr[u] * 32 + lane] : (f32x2){0.f, 0.f};
#pragma unroll
                for (int j = 0; j < 4; ++j) zz[u][j] = *(const h8*)(Z16 + (size_t)tr[u] * D + 512 * j + 8 * lane); }
#pragma unroll
            for (int u = 0; u < 8; ++u) {
                float s0 = pr[u].x, q0 = pr[u].y;
#pragma unroll
                for (int o = 1; o < 64; o <<= 1) { s0 += __shfl_xor(s0, o); q0 += __shfl_xor(q0, o); }
                const float m0 = s0 * (1.0f / D); const float r0 = 1.0f / sqrtf(fmaxf(q0 * (1.0f / D) - m0 * m0, 0.f) + LN_EPS);
                if (u == 0 || tr[u] != tr[0]) { float* o0 = a.out + (size_t)tr[u] * D + 8 * lane;
#pragma unroll
                    for (int j = 0; j < 4; ++j) {
                        const f32x4 a0 = (f32x4){(float)zz[u][j][0], (float)zz[u][j][1], (float)zz[u][j][2], (float)zz[u][j][3]}, a1 = (f32x4){(float)zz[u][j][4], (float)zz[u][j][5], (float)zz[u][j][6], (float)zz[u][j][7]};
                        const f32x4 g0 = *(const f32x4*)(a.ln_g + 512 * j + 8 * lane), g1 = *(const f32x4*)(a.ln_g + 512 * j + 8 * lane + 4), b0 = *(const f32x4*)(a.ln_b + 512 * j + 8 * lane), b1 = *(const f32x4*)(a.ln_b + 512 * j + 8 * lane + 4);
                        *(f32x4*)(o0 + 512 * j) = (a0 - m0) * r0 * g0 + b0; *(f32x4*)(o0 + 512 * j + 4) = (a1 - m0) * r0 * g1 + b1;
                    } }
            }
        }
    }
}

extern "C" void kernel_launch(void* const* d_in, const int* in_sizes, int n_in, void* d_out, int out_size, void* d_ws, size_t ws_size, hipStream_t stream) {
    static int grid = 0;
    if (grid == 0) {
        if (n_in != 10 || in_sizes[0] != M * D || out_size != M * D || ws_size < WS_END) { fprintf(stderr, "kernel_launch: unexpected shapes (n_in %d, in0 %d, out %d, ws %zu); nothing launched\n", n_in, n_in > 0 ? in_sizes[0] : -1, out_size, ws_size); grid = -1; return; }
        int dev = 0, cus = 0, per_cu = 0;
        hipGetDevice(&dev); hipDeviceGetAttribute(&cus, hipDeviceAttributeMultiprocessorCount, dev);
        if (hipFuncSetAttribute((const void*)hybrid_fwd, hipFuncAttributeMaxDynamicSharedMemorySize, LDS_BYTES) != hipSuccess) { fprintf(stderr, "kernel_launch: hipFuncSetAttribute failed\n"); grid = -1; return; }
        if (hipOccupancyMaxActiveBlocksPerMultiprocessor(&per_cu, (const void*)hybrid_fwd, 512, LDS_BYTES) != hipSuccess || per_cu < 1) { fprintf(stderr, "kernel_launch: occupancy query says %d blocks per CU\n", per_cu); per_cu = 1; }
        (void)hipGetLastError();
        grid = cus * 1;
    }
    if (grid < 0) return;
    Args a{};
    a.x = (const float*)d_in[0]; a.pos = (const int*)d_in[1]; a.w_in = (const float*)d_in[2]; a.b_gate = (const float*)d_in[3]; a.sinks = (const float*)d_in[4];
    a.w_pa = (const float*)d_in[5]; a.w_pb = (const float*)d_in[6]; a.w_out = (const float*)d_in[7]; a.ln_g = (const float*)d_in[8]; a.ln_b = (const float*)d_in[9];
    a.out = (float*)d_out; a.ws = (unsigned char*)d_ws;
    {
        for (int pn = 0; pn < DIN / 256; ++pn) { const bool f8 = true;
            if (f8) { a.tl_fp8[a.n_fp8++] = (unsigned char)pn; a.fp8mask |= 1ull << pn; } else a.tl_bf16[a.n_bf16++] = (unsigned char)pn; }
    }
    for (int j = 0; j < 64; ++j) a.inv_freq[j] = (float)pow(10000.0, -(double)j / 64.0);
    void* args[] = {&a};
    hipError_t e = hipLaunchCooperativeKernel((const void*)hybrid_fwd, dim3(grid), dim3(512), args, LDS_BYTES, stream);
    if (e != hipSuccess) fprintf(stderr, "kernel_launch: cooperative launch failed: %s (grid %d)\n", hipGetErrorString(e), grid);
}
```
